# Optimizing an MI355X kernel written in HIP

```python
import jax
import jax.numpy as jnp
from jax import lax
import numpy as np

D_MODEL = 1024
BATCH = 4
SEQ = 4096
DEPTH = 1
DEC_BATCH = 8
DEC_SEQ = 2048
PAST_LEN = 128

RWKV_HEADS = 8
RWKV_HEAD_DIM = 64
RWKV_WIDTH = RWKV_HEADS * RWKV_HEAD_DIM
DECAY_LORA = 64
ICLR_LORA = 64
GATE_LORA = 128
RET_HEADS = 4
RET_HEAD_DIM = 128
RET_WIDTH = RET_HEADS * RET_HEAD_DIM
RET_CHUNK = 128
ROPE_BASE = 10000.0
D_FF = 2816
RWKV_COLS = 3 * RWKV_WIDTH + DECAY_LORA + ICLR_LORA + GATE_LORA
RET_COLS = 4 * RET_WIDTH
IN_COLS = RWKV_COLS + RET_COLS + 2 * D_MODEL
ALPHA = (2.0 * DEPTH) ** 0.25
BETA = (8.0 * DEPTH) ** -0.25
LN_EPS = 1e-5
RWKV_GN_EPS = 64e-5
RET_GN_EPS = 1e-6
F32 = jnp.float32

kernel_name = 'hybrid_rwkv7_retention_macaron_encoder'


def layer_norm(x, g, b, eps=LN_EPS):
    xf = x.astype(F32)
    mu = jnp.mean(xf, axis=-1, keepdims=True)
    var = jnp.mean(jnp.square(xf - mu), axis=-1, keepdims=True)
    return ((xf - mu) * lax.rsqrt(var + eps) * g + b).astype(x.dtype)


def head_norm(y, eps):
    yf = y.astype(F32)
    mu = jnp.mean(yf, axis=-1, keepdims=True)
    var = jnp.mean(jnp.square(yf - mu), axis=-1, keepdims=True)
    return (yf - mu) * lax.rsqrt(var + eps)


def swiglu(x, w_up, w_down):
    gate, up = jnp.split(x @ w_up, 2, axis=-1)
    return (jax.nn.silu(gate) * up) @ w_down


def centred_shift(u, mu_prev, mu_next):
    zero = jnp.zeros_like(u[:, :1])
    prev = jnp.concatenate([zero, u[:, :-1]], axis=1)
    nxt = jnp.concatenate([u[:, 1:], zero], axis=1)
    return u + mu_prev * (prev - u) + mu_next * (nxt - u)


def both_dirs(t_fwd, t_bwd):
    s = jnp.stack([t_fwd, jnp.flip(t_bwd, axis=1)], axis=0)
    return jnp.moveaxis(s, 2, 0).astype(F32)


def rwkv7_scan(r, w, k, v, a, b):
    def step(S, inp):
        r_t, w_t, k_t, v_t, a_t, b_t = inp
        sa = jnp.einsum('dbhvk,dbhk->dbhv', S, a_t)
        S = S * w_t[..., None, :] + sa[..., :, None] * b_t[..., None, :] + v_t[..., :, None] * k_t[..., None, :]
        return S, jnp.einsum('dbhvk,dbhk->dbhv', S, r_t)
    S0 = jnp.zeros(r.shape[1:] + (r.shape[-1],), F32)
    _, y = lax.scan(step, S0, (r, w, k, v, a, b))
    return y


def rwkv7_branch(u, mu_prev, mu_next, w0, w2, a0, a2, g2, k_k, k_a, r_k, lnx_g, lnx_b):
    B, T, _ = u.shape
    H, N, W = RWKV_HEADS, RWKV_HEAD_DIM, RWKV_WIDTH
    u = centred_shift(u, mu_prev, mu_next)
    r, k, v, xw, xa, xg = jnp.split(
        u, [W, 2 * W, 3 * W, 3 * W + DECAY_LORA, 3 * W + DECAY_LORA + ICLR_LORA], axis=-1)
    heads = lambda t: t.reshape(t.shape[:-1] + (H, N))
    w_log = -jax.nn.softplus(-(w0[:, None, None, :] + jnp.einsum('btr,drc->dbtc', jnp.tanh(xw), w2))) - 0.5
    decay = heads(jnp.exp(-jnp.exp(w_log.astype(F32))))
    a = jax.nn.sigmoid(a0[:, None, None, :] + jnp.einsum('btr,drc->dbtc', xa, a2))
    g = jax.nn.sigmoid(xg) @ g2
    kk = heads((k * k_k).astype(F32))
    kk = kk / jnp.maximum(jnp.linalg.norm(kk, axis=-1, keepdims=True), 1e-12)
    k_dir = heads(k[None] * (1.0 + (a - 1.0) * k_a))
    b_dir = kk[None] * heads(a)
    r_h, v_h = heads(r), heads(v)
    y = rwkv7_scan(both_dirs(r_h, r_h), both_dirs(decay[0], decay[1]), both_dirs(k_dir[0], k_dir[1]),
                   both_dirs(v_h, v_h), both_dirs(-kk, -kk), both_dirs(b_dir[0], b_dir[1]))
    y = jnp.moveaxis(y, 0, 2)
    y = y[0] + jnp.flip(y[1], axis=1)
    y = head_norm(y, RWKV_GN_EPS) * heads(lnx_g) + heads(lnx_b)
    bonus = jnp.sum(jnp.sum(r_h[None] * k_dir * r_k, axis=-1, keepdims=True), axis=0)
    y = (y + bonus * v_h).reshape(B, T, W)
    return (y * g).astype(u.dtype)


def rotate_every_two(x):
    x1 = x[..., ::2]
    x2 = x[..., 1::2]
    return jnp.stack([-x2, x1], axis=-1).reshape(x.shape)


def retention_branch(u, pos):
    B, T, _ = u.shape
    H, D, C = RET_HEADS, RET_HEAD_DIM, RET_CHUNK
    NC = T // C
    q, k, v, g = jnp.split(u, 4, axis=-1)
    q, k, v = (t.reshape(B, T, H, D) for t in (q, k, v))
    angle = jnp.repeat(1.0 / (ROPE_BASE ** jnp.linspace(0.0, 1.0, D // 2, dtype=F32)), 2)
    theta = pos[:, None] * angle[None, :]
    sin, cos = jnp.sin(theta)[:, None, :], jnp.cos(theta)[:, None, :]
    q = q * cos + rotate_every_two(q) * sin
    k = (k * cos + rotate_every_two(k) * sin) * (D ** -0.5)
    log_g = jnp.log(1.0 - 2.0 ** (-5.0 - jnp.arange(H, dtype=F32)))
    idx = jnp.arange(C, dtype=F32)
    qc = q.reshape(B, NC, C, H, D)
    kc = k.reshape(B, NC, C, H, D)
    vc = v.reshape(B, NC, C, H, D)
    intra = jnp.exp(log_g[:, None, None] * jnp.abs(idx[:, None] - idx[None, :]))
    scores = jnp.einsum('bnihd,bnjhd->bnhij', qc, kc) * intra
    o = jnp.einsum('bnhij,bnjhd->bnihd', scores, vc)
    kv_f = jnp.einsum('bnjhd,hj,bnjhe->nbhde', kc, jnp.exp(log_g[:, None] * (C - 1.0 - idx)[None]), vc)
    kv_b = jnp.einsum('bnjhd,hj,bnjhe->nbhde', kc, jnp.exp(log_g[:, None] * idx[None]), vc)
    kv = jnp.stack([kv_f, jnp.flip(kv_b, axis=0)], axis=1).astype(F32)
    decay_chunk = jnp.exp(log_g * C)[:, None, None]

    def step(R, kv_n):
        return decay_chunk * R + kv_n, R

    _, states = lax.scan(step, jnp.zeros(kv.shape[1:], F32), kv)
    st_f = states[:, 0]
    st_b = jnp.flip(states[:, 1], axis=0)
    o = (o
         + jnp.einsum('bnihd,hi,nbhde->bnihe', qc, jnp.exp(log_g[:, None] * (idx + 1.0)[None]), st_f)
         + jnp.einsum('bnihd,hi,nbhde->bnihe', qc, jnp.exp(log_g[:, None] * (C - idx)[None]), st_b))
    o = head_norm(o.reshape(B, T, H, D), RET_GN_EPS).reshape(B, T, H * D)
    return (jax.nn.silu(g.astype(F32)) * o).astype(u.dtype)


def encoder_layer(x, ffn1_up, ffn1_down, ln1_g, ln1_b, w_in, shift_prev, shift_next,
                  rwkv_w0, rwkv_w2, rwkv_a0, rwkv_a2, rwkv_g2, rwkv_k_k, rwkv_k_a, rwkv_r_k,
                  rwkv_lnx_g, rwkv_lnx_b, w_branch_a, w_branch_b, w_out, ln2_g, ln2_b,
                  ffn2_up, ffn2_down, ln3_g, ln3_b):
    pos = jnp.arange(x.shape[1], dtype=F32)
    x = layer_norm(ALPHA * x + 0.5 * swiglu(x, ffn1_up, ffn1_down), ln1_g, ln1_b)
    u = x @ w_in
    u_a, u_b, gate_a, gate_b = jnp.split(
        u, [RWKV_COLS, RWKV_COLS + RET_COLS, RWKV_COLS + RET_COLS + D_MODEL], axis=-1)
    h_a = rwkv7_branch(u_a, shift_prev, shift_next, rwkv_w0, rwkv_w2, rwkv_a0, rwkv_a2, rwkv_g2,
                       rwkv_k_k, rwkv_k_a, rwkv_r_k, rwkv_lnx_g, rwkv_lnx_b) @ w_branch_a
    h_b = retention_branch(u_b, pos) @ w_branch_b
    mix = (jax.nn.sigmoid(gate_a) * h_a + jax.nn.sigmoid(gate_b) * h_b) @ w_out
    x = layer_norm(ALPHA * x + mix, ln2_g, ln2_b)
    x = layer_norm(ALPHA * x + 0.5 * swiglu(x, ffn2_up, ffn2_down), ln3_g, ln3_b)
    return x


def setup_inputs(seed: int = 0) -> dict:
    key = jax.random.key(seed)
    ks = iter(jax.random.split(key, 40))

    def nrm(shape, scale):
        return scale * jax.random.normal(next(ks), shape, F32)

    def uni(shape, lo, hi):
        return jax.random.uniform(next(ks), shape, F32, lo, hi)

    L, D, W = DEPTH, D_MODEL, RWKV_WIDTH
    ch = jnp.arange(W, dtype=F32) / (W - 1)
    w0_base = -6.0 + 5.0 * ch ** 0.9 + 0.5
    return {
        'x_prompt': nrm((BATCH, SEQ, D), 1.0),
        'x_sample': nrm((DEC_BATCH, DEC_SEQ, D), 1.0),
        'ffn1_up': nrm((L, D, 2 * D_FF), D ** -0.5),
        'ffn1_down': nrm((L, D_FF, D), BETA * D_FF ** -0.5),
        'ln1_g': 1.0 + nrm((L, D), 0.02),
        'ln1_b': nrm((L, D), 0.02),
        'w_in': nrm((L, D, IN_COLS), D ** -0.5),
        'shift_prev': uni((L, RWKV_COLS), 0.0, 0.5),
        'shift_next': uni((L, RWKV_COLS), 0.0, 0.5),
        'rwkv_w0': w0_base + nrm((L, 2, W), 0.1),
        'rwkv_w2': nrm((L, 2, DECAY_LORA, W), 0.1 * DECAY_LORA ** -0.5),
        'rwkv_a0': nrm((L, 2, W), 0.1),
        'rwkv_a2': nrm((L, 2, ICLR_LORA, W), 0.5 * ICLR_LORA ** -0.5),
        'rwkv_g2': nrm((L, GATE_LORA, W), GATE_LORA ** -0.5),
        'rwkv_k_k': 0.85 + nrm((L, W), 0.02),
        'rwkv_k_a': 1.0 + nrm((L, W), 0.02),
        'rwkv_r_k': nrm((L, RWKV_HEADS, RWKV_HEAD_DIM), 0.1),
        'rwkv_lnx_g': 1.0 + nrm((L, W), 0.02),
        'rwkv_lnx_b': nrm((L, W), 0.02),
        'w_branch_a': nrm((L, W, D), BETA * W ** -0.5),
        'w_branch_b': nrm((L, RET_WIDTH, D), BETA * RET_WIDTH ** -0.5),
        'w_out': nrm((L, D, D), BETA * D ** -0.5),
        'ln2_g': 1.0 + nrm((L, D), 0.02),
        'ln2_b': nrm((L, D), 0.02),
        'ffn2_up': nrm((L, D, 2 * D_FF), D ** -0.5),
        'ffn2_down': nrm((L, D_FF, D), BETA * D_FF ** -0.5),
        'ln3_g': 1.0 + nrm((L, D), 0.02),
        'ln3_b': nrm((L, D), 0.02),
    }


def reference(x_prompt, x_sample, ffn1_up, ffn1_down, ln1_g, ln1_b, w_in, shift_prev, shift_next,
              rwkv_w0, rwkv_w2, rwkv_a0, rwkv_a2, rwkv_g2, rwkv_k_k, rwkv_k_a, rwkv_r_k,
              rwkv_lnx_g, rwkv_lnx_b, w_branch_a, w_branch_b, w_out, ln2_g, ln2_b,
              ffn2_up, ffn2_down, ln3_g, ln3_b):
    params = (ffn1_up, ffn1_down, ln1_g, ln1_b, w_in, shift_prev, shift_next,
              rwkv_w0, rwkv_w2, rwkv_a0, rwkv_a2, rwkv_g2, rwkv_k_k, rwkv_k_a, rwkv_r_k,
              rwkv_lnx_g, rwkv_lnx_b, w_branch_a, w_branch_b, w_out, ln2_g, ln2_b,
              ffn2_up, ffn2_down, ln3_g, ln3_b)
    y_prompt = x_prompt
    y_sample = x_sample
    for l in range(DEPTH):
        layer_params = [p[l] for p in params]
        y_prompt = encoder_layer(y_prompt, *layer_params)
        y_sample = encoder_layer(y_sample, *layer_params)
    return (y_prompt, y_sample)
```

```cpp
#include <hip/hip_runtime.h>
#include <cstdio>
#include <cstdint>
#include <cmath>
namespace pg8 {
#define PG8_LAS __attribute__((address_space(3)))
typedef unsigned short bf16_t;
typedef short bf16x8 __attribute__((ext_vector_type(8)));
typedef float f32x4 __attribute__((ext_vector_type(4)));
typedef unsigned u32x4 __attribute__((ext_vector_type(4)));
constexpr int BM = 256, BK = 64, HALF = 128, HTB = HALF * BK * 2  , STAGE_BYTES = 8 * HTB, NXCD = 8, WGM = 8;

__host__ __device__ __forceinline__ int lds_byte(int r, int c) { const int st = (r >> 4) * 2 + (c >> 5), rr = r & 15, cc = c & 31, ob = rr * 64 + cc * 2; return st * 1024 + (ob ^ (((ob >> 9) & 1) << 5)); }
__host__ __device__ __forceinline__ void stage_rc(int b, int& R, int& C) { const int st = b / 1024, sb = b % 1024, swz = sb ^ (((sb >> 9) & 1) << 5); R = (st >> 1) * 16 + swz / 64; C = (st & 1) * 32 + (swz % 64) / 2; }
__host__ __device__ __forceinline__ int perm32(int rho) { const int n = rho >> 4, i = rho & 15; return 8 * (i >> 2) + 4 * n + (i & 3); }

struct Unit { int pm, pn; };
struct Gemm { const bf16_t* A; const bf16_t* Bt; int M, N, K; };

struct StaticOrder {
    int nM, nN, nwg, G, c;
    __host__ __device__ void init(int M, int N, int G_, int c_) { nM = M / BM; nN = N / BM; nwg = nM * nN; G = G_; c = c_; }
    __host__ __device__ bool next(int i, Unit& u) const {
        const long L = (long)i * G + c; if (L >= nwg) return false;
        int wgid = (int)L; { const int q = nwg / NXCD, r = nwg % NXCD, xcd = wgid % NXCD, off = wgid / NXCD; wgid = (xcd < r ? xcd * (q + 1) : r * (q + 1) + (xcd - r) * q) + off; }
        const int nig = WGM * nN, gid = wgid / nig, fm = gid * WGM, gsz = (nM - fm) < WGM ? (nM - fm) : WGM;
        u.pm = fm + ((wgid % nig) % gsz); u.pn = (wgid % nig) / gsz; return true;
    }
    __device__ __forceinline__ void a_ready(const Unit&) const {}
    __device__ __forceinline__ void done(const Unit&) const {}
};

__device__ __forceinline__ unsigned cvt_pk_bf16(float lo, float hi) { unsigned r; asm volatile("v_cvt_pk_bf16_f32 %0, %1, %2" : "=v"(r) : "v"(lo), "v"(hi)); return r; }
typedef float f32x2 __attribute__((ext_vector_type(2)));
__device__ __forceinline__ float sigmoidf_fast(float x) { return __builtin_amdgcn_rcpf(1.0f + __builtin_amdgcn_exp2f(-1.4426950408889634f * x)); }
__device__ __forceinline__ float siluf_fast(float x) { return x * sigmoidf_fast(x); }
__device__ __forceinline__ float bf16_lo(unsigned w) { return __uint_as_float(w << 16); }
__device__ __forceinline__ float bf16_hi(unsigned w) { return __uint_as_float(w & 0xffff0000u); }

struct EpiStoreBf16 {
    static constexpr bool PERM = true, AFTER_DRAIN = false;
    bf16_t* O; int ldc;
    __device__ __forceinline__ void operator()(const f32x4 (&acc)[2][2][4][2], const Unit& u, int wr, int wc, int fr, int fq) const {
        const int row0 = u.pm * BM + wr * 64 + fr, col0 = u.pn * BM + wc * 32 + 8 * fq;
#pragma unroll
        for (int ai = 0; ai < 2; ++ai)
#pragma unroll
            for (int m = 0; m < 4; ++m) { bf16_t* rowp = O + (size_t)(row0 + ai * HALF + m * 16) * ldc + col0;
#pragma unroll
                for (int bj = 0; bj < 2; ++bj) { const f32x4 v0 = acc[ai][bj][m][0], v1 = acc[ai][bj][m][1];
                    u32x4 w; w.x = cvt_pk_bf16(v0[0], v0[1]); w.y = cvt_pk_bf16(v0[2], v0[3]); w.z = cvt_pk_bf16(v1[0], v1[1]); w.w = cvt_pk_bf16(v1[2], v1[3]);
                    *(u32x4*)(rowp + bj * HALF) = w; } }
    }
};
struct EpiSwiglu {
    static constexpr bool PERM = true, AFTER_DRAIN = false;
    bf16_t* H; int ldh;
    __device__ __forceinline__ void operator()(const f32x4 (&acc)[2][2][4][2], const Unit& u, int wr, int wc, int fr, int fq) const {
        const int row0 = u.pm * BM + wr * 64 + fr, col0 = u.pn * HALF + wc * 32 + 8 * fq;
#pragma unroll
        for (int ai = 0; ai < 2; ++ai)
#pragma unroll
            for (int m = 0; m < 4; ++m) { bf16_t* rowp = H + (size_t)(row0 + ai * HALF + m * 16) * ldh + col0;
                const f32x4 g0 = acc[ai][0][m][0], g1 = acc[ai][0][m][1], u0 = acc[ai][1][m][0], u1 = acc[ai][1][m][1];
                float h[8];
#pragma unroll
                for (int i = 0; i < 4; ++i) { h[i] = siluf_fast(g0[i]) * u0[i]; h[4 + i] = siluf_fast(g1[i]) * u1[i]; }
                u32x4 w; w.x = cvt_pk_bf16(h[0], h[1]); w.y = cvt_pk_bf16(h[2], h[3]); w.z = cvt_pk_bf16(h[4], h[5]); w.w = cvt_pk_bf16(h[6], h[7]);
                *(u32x4*)rowp = w; }
    }
};
struct EpiGateMul {
    static constexpr bool PERM = true, AFTER_DRAIN = false;
    bf16_t* HB; int ldc;
    __device__ __forceinline__ void operator()(const f32x4 (&acc)[2][2][4][2], const Unit& u, int wr, int wc, int fr, int fq) const {
        const int row0 = u.pm * BM + wr * 64 + fr, col0 = u.pn * BM + wc * 32 + 8 * fq;
#pragma unroll
        for (int ai = 0; ai < 2; ++ai)
#pragma unroll
            for (int m = 0; m < 4; ++m) { bf16_t* rowp = HB + (size_t)(row0 + ai * HALF + m * 16) * ldc + col0;
#pragma unroll
                for (int bj = 0; bj < 2; ++bj) { const f32x4 v0 = acc[ai][bj][m][0], v1 = acc[ai][bj][m][1];
                    const u32x4 hb = *(const u32x4*)(rowp + bj * HALF);
                    u32x4 w;
                    w.x = cvt_pk_bf16(sigmoidf_fast(v0[0]) * bf16_lo(hb.x), sigmoidf_fast(v0[1]) * bf16_hi(hb.x));
                    w.y = cvt_pk_bf16(sigmoidf_fast(v0[2]) * bf16_lo(hb.y), sigmoidf_fast(v0[3]) * bf16_hi(hb.y));
                    w.z = cvt_pk_bf16(sigmoidf_fast(v1[0]) * bf16_lo(hb.z), sigmoidf_fast(v1[1]) * bf16_hi(hb.z));
                    w.w = cvt_pk_bf16(sigmoidf_fast(v1[2]) * bf16_lo(hb.w), sigmoidf_fast(v1[3]) * bf16_hi(hb.w));
                    *(u32x4*)(rowp + bj * HALF) = w; } }
    }
};
template <int RES> struct EpiResidual {
    static constexpr bool PERM = false, AFTER_DRAIN = false;
    const float* r0; const float* r1; int split; const bf16_t* rb; float* out; int ldc; float alpha, scale;
    __device__ __forceinline__ void operator()(const f32x4 (&acc)[2][2][4][2], const Unit& u, int wr, int wc, int fr, int fq) const {
        const int row0 = u.pm * BM + wr * 64 + fr, col0 = u.pn * BM + wc * 32 + 4 * fq;
#pragma unroll
        for (int ai = 0; ai < 2; ++ai)
#pragma unroll
            for (int m = 0; m < 4; ++m) { const int row = row0 + ai * HALF + m * 16;
                const float* resf = (row < split) ? r0 + (size_t)row * ldc : r1 + (size_t)(row - split) * ldc;
#pragma unroll
                for (int bj = 0; bj < 2; ++bj)
#pragma unroll
                    for (int n = 0; n < 2; ++n) { const int c = col0 + bj * HALF + n * 16; f32x4 rv;
                        if (RES == 0) rv = *(const f32x4*)(resf + c);
                        else { const unsigned long long w = *(const unsigned long long*)(rb + (size_t)row * ldc + c); const unsigned lo = (unsigned)w, hi = (unsigned)(w >> 32);
                            rv = (f32x4){bf16_lo(lo), bf16_hi(lo), bf16_lo(hi), bf16_hi(hi)}; }
                        *(f32x4*)(out + (size_t)row * ldc + c) = rv * alpha + acc[ai][bj][m][n] * scale; } }
    }
};

template <class Epi, class Sched, bool ALIGN_EPI = false, bool SP2 = false>
__device__ __forceinline__ void gemm_phase(PG8_LAS unsigned char* lds, const Gemm g, const Sched& S, const Epi& E) {
    const int tid = threadIdx.x, wid = __builtin_amdgcn_readfirstlane(tid >> 6), lane = tid & 63, wr = wid >> 2, wc = wid & 3, fr = lane & 15, fq = lane >> 4;
    const int K = g.K, nt = K / BK;
    unsigned voffA[2], voffB[2];
#pragma unroll
    for (int i = 0; i < 2; ++i) { int R, C; stage_rc(tid * 16 + i * 8192, R, C); const int Rb = Epi::PERM ? ((R & ~31) + perm32(R & 31)) : R;
        voffA[i] = (unsigned)(R * K + C) * 2u; voffB[i] = (unsigned)(Rb * K + C) * 2u; }
    const size_t kstep = (size_t)(BK * 2);
    const size_t hstep = (size_t)HALF * K * 2;
    const size_t tstep = 2 * hstep;
    const unsigned ldsw = (unsigned)wid * 1024u;
    const int aoff = lds_byte(wr * 64 + fr, fq * 8), boff = lds_byte(wc * 32 + fr, fq * 8);
#define PG8_SA(b, h) (((b) * 2 + (h)) * HTB)
#define PG8_SB(b, h) ((4 + (b) * 2 + (h)) * HTB)
#define PG8_STAGE(bufoff, gbase, voff) do { _Pragma("unroll") for (int _i = 0; _i < 2; ++_i) \
        __builtin_amdgcn_global_load_lds((const unsigned*)((const char*)(gbase) + (voff)[_i]), (PG8_LAS unsigned*)(lds + (bufoff) + ldsw + _i * 8192), 16, 0, 0); } while (0)
#define PG8_LDA(dst, b, h) do { _Pragma("unroll") for (int m = 0; m < 4; ++m) _Pragma("unroll") for (int k = 0; k < 2; ++k) dst[m][k] = *(const PG8_LAS bf16x8*)(lds + PG8_SA(b, h) + aoff + m * 2048 + k * 1024); } while (0)
#define PG8_LDB(dst, b, h) do { _Pragma("unroll") for (int n = 0; n < 2; ++n) _Pragma("unroll") for (int k = 0; k < 2; ++k) dst[n][k] = *(const PG8_LAS bf16x8*)(lds + PG8_SB(b, h) + boff + n * 2048 + k * 1024); } while (0)
#define PG8_MMA(ai, bj, At, Bt) do { __builtin_amdgcn_s_setprio(1); _Pragma("unroll") for (int m = 0; m < 4; ++m) _Pragma("unroll") for (int n = 0; n < 2; ++n) _Pragma("unroll") for (int k = 0; k < 2; ++k) \
        acc[ai][bj][m][n] = __builtin_amdgcn_mfma_f32_16x16x32_bf16(Bt[n][k], At[m][k], acc[ai][bj][m][n], 0, 0, 0); __builtin_amdgcn_s_setprio(0); } while (0)
#define PG8_WAIT_V(n) asm volatile("s_waitcnt vmcnt(" #n ")" ::: "memory")
#define PG8_WAIT_L(n) asm volatile("s_waitcnt lgkmcnt(" #n ")" ::: "memory")
#define PG8_BAR __builtin_amdgcn_s_barrier()
#define PG8_SCHED __builtin_amdgcn_sched_barrier(0)
    Unit cur, nxt; int ui = 0;
    if (!S.next(0, cur)) return;
    f32x4 acc[2][2][4][2];
#pragma unroll
    for (int a = 0; a < 2; ++a)
#pragma unroll
        for (int b = 0; b < 2; ++b)
#pragma unroll
            for (int m = 0; m < 4; ++m)
#pragma unroll
                for (int n = 0; n < 2; ++n) acc[a][b][m][n] = (f32x4){0.f, 0.f, 0.f, 0.f};
    bf16x8 At[4][2], B0[2][2], B1[2][2];
    const char* cA = (const char*)g.A + (size_t)cur.pm * tstep; const char* cB = (const char*)g.Bt + (size_t)cur.pn * tstep;
    S.a_ready(cur);
    if constexpr (SP2) {
        PG8_STAGE(PG8_SB(0, 0), cB, voffB); PG8_STAGE(PG8_SB(0, 1), cB + hstep, voffB); PG8_STAGE(PG8_SA(0, 0), cA, voffA); PG8_STAGE(PG8_SA(0, 1), cA + hstep, voffA);
        if (wr == 1) PG8_BAR;
        PG8_WAIT_V(2); PG8_BAR;
        PG8_STAGE(PG8_SB(1, 0), cB + kstep, voffB); PG8_STAGE(PG8_SA(1, 0), cA + kstep, voffA); PG8_STAGE(PG8_SB(1, 1), cB + hstep + kstep, voffB);
        PG8_WAIT_V(6); PG8_BAR;
    } else {
        PG8_STAGE(PG8_SB(0, 0), cB, voffB); PG8_STAGE(PG8_SA(0, 0), cA, voffA); PG8_STAGE(PG8_SB(0, 1), cB + hstep, voffB); PG8_STAGE(PG8_SA(0, 1), cA + hstep, voffA);
        if (wr == 1) PG8_BAR;
        PG8_WAIT_V(4); PG8_BAR;
        PG8_STAGE(PG8_SB(1, 0), cB + kstep, voffB); PG8_STAGE(PG8_SA(1, 0), cA + kstep, voffA); PG8_STAGE(PG8_SB(1, 1), cB + hstep + kstep, voffB);
        PG8_WAIT_V(6); PG8_BAR;
    }
    for (;;) {
        const bool has_next = S.next(ui + 1, nxt);
        const char* nA = has_next ? (const char*)g.A + (size_t)nxt.pm * tstep : cA; const char* nB = has_next ? (const char*)g.Bt + (size_t)nxt.pn * tstep : cB;
        for (int t = 0; t < nt; t += 2) {
            const bool last = (t == nt - 2);
            const char* a1 = cA + (size_t)(t + 1) * kstep;
            const char* a2 = last ? nA : cA + (size_t)(t + 2) * kstep; const char* b2 = last ? nB : cB + (size_t)(t + 2) * kstep;
            const char* a3 = a2 + kstep; const char* b3 = b2 + kstep;
            if (last && has_next) S.a_ready(nxt);
            if constexpr (SP2) {
            PG8_LDB(B0, 0, 0); PG8_LDB(B1, 0, 1); PG8_SCHED; PG8_LDA(At, 0, 0); PG8_STAGE(PG8_SA(1, 1), a1 + hstep, voffA);
            PG8_WAIT_V(8); PG8_WAIT_L(0); PG8_BAR; PG8_MMA(0, 0, At, B0); PG8_MMA(0, 1, At, B1); PG8_BAR; PG8_SCHED;
            PG8_LDA(At, 0, 1); PG8_STAGE(PG8_SB(0, 0), b2, voffB); PG8_STAGE(PG8_SB(0, 1), b2 + hstep, voffB); PG8_STAGE(PG8_SA(0, 0), a2, voffA);
            PG8_WAIT_V(8); PG8_WAIT_L(0); PG8_BAR; PG8_MMA(1, 0, At, B0); PG8_MMA(1, 1, At, B1); PG8_BAR; PG8_SCHED;
            PG8_LDB(B0, 1, 0); PG8_LDB(B1, 1, 1); PG8_SCHED; PG8_LDA(At, 1, 0); PG8_STAGE(PG8_SA(0, 1), a2 + hstep, voffA);
            PG8_WAIT_V(8); PG8_WAIT_L(0); PG8_BAR; PG8_MMA(0, 0, At, B0); PG8_MMA(0, 1, At, B1); PG8_BAR; PG8_SCHED;
            PG8_LDA(At, 1, 1); PG8_STAGE(PG8_SB(1, 0), b3, voffB); PG8_STAGE(PG8_SB(1, 1), b3 + hstep, voffB); PG8_STAGE(PG8_SA(1, 0), a3, voffA);
            PG8_WAIT_V(8); PG8_WAIT_L(0); PG8_BAR; PG8_MMA(1, 0, At, B0); PG8_MMA(1, 1, At, B1); PG8_BAR; PG8_SCHED;
            } else {
            PG8_LDB(B0, 0, 0); PG8_SCHED; PG8_LDA(At, 0, 0); PG8_STAGE(PG8_SA(1, 1), a1 + hstep, voffA);
            PG8_WAIT_L(8); PG8_BAR; PG8_WAIT_L(0); PG8_MMA(0, 0, At, B0); PG8_BAR; PG8_SCHED;
            PG8_LDB(B1, 0, 1); PG8_STAGE(PG8_SB(0, 0), b2, voffB);
            PG8_BAR; PG8_WAIT_L(0); PG8_MMA(0, 1, At, B1); PG8_BAR;
            PG8_LDA(At, 0, 1); PG8_STAGE(PG8_SA(0, 0), a2, voffA);
            PG8_BAR; PG8_WAIT_L(0); PG8_MMA(1, 0, At, B0); PG8_BAR; PG8_SCHED;
            PG8_STAGE(PG8_SB(0, 1), b2 + hstep, voffB);
            PG8_WAIT_V(6); PG8_BAR; PG8_MMA(1, 1, At, B1); PG8_BAR;
            PG8_LDB(B0, 1, 0); PG8_SCHED; PG8_LDA(At, 1, 0); PG8_STAGE(PG8_SA(0, 1), a2 + hstep, voffA);
            PG8_WAIT_L(8); PG8_BAR; PG8_WAIT_L(0); PG8_MMA(0, 0, At, B0); PG8_BAR; PG8_SCHED;
            PG8_LDB(B1, 1, 1); PG8_STAGE(PG8_SB(1, 0), b3, voffB);
            PG8_BAR; PG8_WAIT_L(0); PG8_MMA(0, 1, At, B1); PG8_BAR;
            PG8_LDA(At, 1, 1); PG8_STAGE(PG8_SA(1, 0), a3, voffA);
            PG8_BAR; PG8_WAIT_L(0); PG8_MMA(1, 0, At, B0); PG8_BAR; PG8_SCHED;
            PG8_STAGE(PG8_SB(1, 1), b3 + hstep, voffB);
            PG8_WAIT_V(6); PG8_BAR; PG8_MMA(1, 1, At, B1); PG8_BAR;
            }
        }
        if constexpr (ALIGN_EPI) { if (wr == 0) PG8_BAR; }
        if constexpr (!Epi::AFTER_DRAIN) { E(acc, cur, wr, wc, fr, fq); S.done(cur); }
        if (!has_next) break;
#pragma unroll
        for (int a = 0; a < 2; ++a)
#pragma unroll
            for (int b = 0; b < 2; ++b)
#pragma unroll
                for (int m = 0; m < 4; ++m)
#pragma unroll
                    for (int n = 0; n < 2; ++n) acc[a][b][m][n] = (f32x4){0.f, 0.f, 0.f, 0.f};
        cur = nxt; cA = nA; cB = nB; ++ui;
        if constexpr (ALIGN_EPI) { if (wr == 1) PG8_BAR; }
    }
    PG8_WAIT_V(0);
    if constexpr (!ALIGN_EPI) { if (wr == 0) PG8_BAR; }
    PG8_BAR;
    if constexpr (Epi::AFTER_DRAIN) { E.fused(acc, cur, wr, wc, fr, fq, lds, wid, lane); S.done(cur); }
#undef PG8_SA
#undef PG8_SB
#undef PG8_STAGE
#undef PG8_LDA
#undef PG8_LDB
#undef PG8_MMA
#undef PG8_WAIT_V
#undef PG8_WAIT_L
#undef PG8_BAR
#undef PG8_SCHED
}
}

constexpr int NWAVES = 8;
constexpr int NTOK = 32768, NTOK_P = 16384, DM = 1024, DFF = 2816;
constexpr int RWKV_COLS = 1792, RET_COLS = 2048, GATE_COLS = 2048, IN_COLS = 5888;
constexpr float ALPHA = 1.189207115002721f, LN_EPS = 1e-5f;
constexpr size_t MiB = 1u << 20;
constexpr size_t WS_CTL = 0, CTL_ZERO_BYTES = 1 * MiB;
constexpr size_t WS_W_UP2 = 1 * MiB;
constexpr size_t WS_W_DN2 = 1 * MiB;
constexpr size_t WS_W_UP1 = 12 * MiB;
constexpr size_t WS_W_DN1 = 23 * MiB;
constexpr size_t WS_W_IN = 29 * MiB;
constexpr size_t WS_W_BR = 41 * MiB;
constexpr size_t WS_W_OUT = 43 * MiB;
constexpr size_t WS_TAB = 47 * MiB;
constexpr size_t WS_X1B = 49 * MiB;
constexpr size_t WS_BIG = 113 * MiB;
constexpr size_t WS_BONUS = 242 * MiB;
constexpr size_t WS_H1 = 49 * MiB;
constexpr size_t WS_X2B = 12 * MiB;
constexpr size_t WS_H2 = 76 * MiB;
constexpr size_t WS_END = 256 * MiB;
constexpr size_t DO_XB = 0;
constexpr size_t DO_YF = 0, DO_YBW = 32 * MiB;
constexpr size_t DO_YB = 64 * MiB;
constexpr size_t DO_YA = 96 * MiB;
constexpr int CW_BAR = 4096;
constexpr int RING_OFF = 0, RING_BYTES = 131072;
constexpr int LDSCTL_OFF = RING_BYTES, MISC_OFF = LDSCTL_OFF + 320;
constexpr int LDS_BYTES = 147456;
#define GAS __attribute__((address_space(1)))
#define LAS __attribute__((address_space(3)))
typedef unsigned short bf16;
typedef unsigned v4u __attribute__((ext_vector_type(4)));
typedef float f32x4 __attribute__((ext_vector_type(4)));
typedef short bf16x8 __attribute__((ext_vector_type(8)));
typedef GAS unsigned gu32;
typedef GAS unsigned long long gu64;
#define RLX_AGENT __ATOMIC_RELAXED, __HIP_MEMORY_SCOPE_AGENT
#define LDS_WAIT() asm volatile("s_waitcnt lgkmcnt(0)" ::: "memory")
#define VM_WAIT() asm volatile("s_waitcnt vmcnt(0)" ::: "memory")
__device__ __forceinline__ unsigned long long rt() { return __builtin_amdgcn_s_memrealtime(); }
__device__ __forceinline__ unsigned f2bf(float f) { unsigned u = __builtin_bit_cast(unsigned, f); return (u + 0x7fffu + ((u >> 16) & 1u)) >> 16; }
__device__ __forceinline__ unsigned pk2(float lo, float hi) { return f2bf(lo) | (f2bf(hi) << 16); }

#define XB_TMO      128
#define XB_XCNT(j)  (256  + 64 * (j))
#define XB_XSUB(j)  (1280 + 64 * (j))
#define XB_XGEN(j)  (2304 + 64 * (j))
#define XB_TOP      3328
#define XB_TOPGEN   3392
#define XCD_BAR_WORDS 3456
#define XB_SPIN_CAP (1u << 18)

__device__ __forceinline__ unsigned xb_ld(unsigned* p)              { return __hip_atomic_load(p, __ATOMIC_RELAXED, __HIP_MEMORY_SCOPE_AGENT); }
__device__ __forceinline__ unsigned xb_add(unsigned* p, unsigned v) { return __hip_atomic_fetch_add(p, v, __ATOMIC_RELAXED, __HIP_MEMORY_SCOPE_AGENT); }
__device__ __forceinline__ unsigned xb_xcc_id() { return (unsigned)__builtin_amdgcn_s_getreg((3 << 11) | 20) & 0xFu; }
#define XB_SPIN(cond, bar) do { unsigned _sp = 0; while (cond) { __builtin_amdgcn_s_sleep(1); \
    if ((++_sp & 255u) == 0u) { if (xb_ld(&(bar)[XB_TMO])) break; if (_sp > XB_SPIN_CAP) { atomicAdd(&(bar)[XB_TMO], 1u); break; } } } } while (0)

struct XcdBarrier {
    unsigned* bar; unsigned x;
    volatile LAS unsigned* st;
};

__device__ __forceinline__ XcdBarrier xcd_barrier_post(unsigned* bar, volatile LAS unsigned* st) {
    XcdBarrier b; b.bar = bar; b.x = xb_xcc_id(); b.st = st;
    if (threadIdx.x == 0) (void)xb_add(&bar[XB_XCNT(b.x)], 1u);
    return b;
}
__device__ __forceinline__ void xcd_barrier_complete(unsigned* bar, unsigned x, unsigned& nloc, unsigned& nx) {
    const unsigned G = gridDim.x * gridDim.y * gridDim.z;
    unsigned sum, cnt, mine, sp = 0u;
    for (;;) {
        sum = 0u; cnt = 0u; mine = 0u;
#pragma unroll
        for (unsigned j = 0; j < 16; ++j) { const unsigned c = xb_ld(&bar[XB_XCNT(j)]); sum += c; cnt += (c > 0u) ? 1u : 0u; mine = (j == x) ? c : mine; }
        if (sum == G) break;
        __builtin_amdgcn_s_sleep(1);
        if ((++sp & 255u) == 0u) { if (xb_ld(&bar[XB_TMO])) break; if (sp > XB_SPIN_CAP) { atomicAdd(&bar[XB_TMO], 1u); break; } }
    }
    nloc = mine > 0u ? mine : 1u; nx = cnt > 0u ? cnt : 1u;
}

__device__ __forceinline__ void xcd_barrier(const XcdBarrier& b) {
    asm volatile("s_waitcnt vmcnt(0)" ::: "memory");
    __syncthreads();
    if (threadIdx.x == 0) {
        unsigned* bar = b.bar;
        __builtin_amdgcn_s_waitcnt(0);
        unsigned nloc = b.st[0], nx = b.st[1];
        if (nloc == 0u) { xcd_barrier_complete(bar, b.x, nloc, nx); b.st[0] = nloc; b.st[1] = nx; }
        const unsigned old = xb_add(&bar[XB_XSUB(b.x)], 1u);
        const unsigned gen = old / nloc;
        if (old + 1u == (gen + 1u) * nloc) {
            __builtin_amdgcn_fence(__ATOMIC_RELEASE, "agent");
            asm volatile("s_waitcnt vmcnt(0)" ::: "memory");
            const unsigned og = xb_add(&bar[XB_TOP], 1u);
            const unsigned tg = og / nx;
            if (og + 1u == (tg + 1u) * nx) xb_add(&bar[XB_TOPGEN], 1u);
            else XB_SPIN(xb_ld(&bar[XB_TOPGEN]) == tg, bar);
            __builtin_amdgcn_fence(__ATOMIC_ACQUIRE, "agent");
            xb_add(&bar[XB_XGEN(b.x)], 1u);
            asm volatile("s_waitcnt vmcnt(0)" ::: "memory");
        } else {
            XB_SPIN(xb_ld(&bar[XB_XGEN(b.x)]) == gen, bar);
            __builtin_amdgcn_fence(__ATOMIC_ACQUIRE, "agent");
            asm volatile("s_waitcnt vmcnt(0)" ::: "memory");
        }
    }
    __syncthreads();
}


__device__ __forceinline__ float wave_sum(float v) {
#pragma unroll
    for (int o = 1; o < 64; o <<= 1) v += __shfl_xor(v, o);
    return v;
}
__device__ __forceinline__ float bflo(unsigned w) { return __uint_as_float(w << 16); }
__device__ __forceinline__ float bfhi(unsigned w) { return __uint_as_float(w & 0xffff0000u); }
__device__ __forceinline__ float bf2f(bf16 h) { return __uint_as_float((unsigned)h << 16); }
__device__ __forceinline__ float sigm(float x) { return 1.0f / (1.0f + __expf(-x)); }
__device__ __forceinline__ void row_geom(int m, int& t, int& T) { if (m < NTOK_P) { t = m & 4095; T = 4096; } else { t = (m - NTOK_P) & 2047; T = 2048; } }
__device__ __forceinline__ void seq_geom(int s, int& row0, int& T) { if (s < 4) { row0 = s * 4096; T = 4096; } else { row0 = NTOK_P + (s - 4) * 2048; T = 2048; } }

__device__ __forceinline__ void p0_transpose_item(const float* W, int N, bf16* WT, int ldk, int koff, int row_off, int mode, LAS float* scr, int item, int lane) {
    const int nblk = N / 32, kb = item / nblk, nb = item % nblk, k0 = 64 * kb, n0 = 32 * nb;
    int drow0 = row_off + n0;
    if (mode == 1) { const int up = n0 >= DFF ? 1 : 0, j0 = n0 - up * DFF; drow0 = (j0 / 128) * 256 + up * 128 + (j0 % 128); }
#pragma unroll 8
    for (int i = 0; i < 32; ++i) { const int kk = 2 * i + (lane >> 5); scr[kk * 33 + (lane & 31)] = W[(size_t)(k0 + kk) * N + n0 + (lane & 31)]; }
    LDS_WAIT(); asm volatile("" ::: "memory");
    const int c = lane & 7;
#pragma unroll
    for (int j = 0; j < 4; ++j) { const int n = (lane >> 3) + 8 * j; const LAS float* s = scr + (8 * c) * 33 + n;
        v4u o; o.x = pk2(s[0 * 33], s[1 * 33]); o.y = pk2(s[2 * 33], s[3 * 33]); o.z = pk2(s[4 * 33], s[5 * 33]); o.w = pk2(s[6 * 33], s[7 * 33]);
        *(GAS v4u*)(WT + (size_t)(drow0 + n) * ldk + koff + k0 + 8 * c) = o; }
    LDS_WAIT(); asm volatile("" ::: "memory");
}

struct Ptrs {
    const float* in[28]; float* out; unsigned char* ws;
};

__device__ __forceinline__ void ln_rows(const float* P, const float* g, const float* b, float* of32, bf16* ob16, int gw, int NGW, int lane) {
    for (int m = gw; m < NTOK; m += NGW) {
        const GAS f32x4* xr = (const GAS f32x4*)(P + (size_t)m * DM) + lane;
        f32x4 v[4]; float s = 0.f;
#pragma unroll
        for (int j = 0; j < 4; ++j) { v[j] = xr[64 * j]; s += (v[j].x + v[j].y) + (v[j].z + v[j].w); }
        const float mean = wave_sum(s) * (1.f / DM); float s2 = 0.f;
#pragma unroll
        for (int j = 0; j < 4; ++j) { v[j] = v[j] - mean; s2 += (v[j].x * v[j].x + v[j].y * v[j].y) + (v[j].z * v[j].z + v[j].w * v[j].w); }
        const float rstd = 1.f / sqrtf(wave_sum(s2) * (1.f / DM) + LN_EPS);
#pragma unroll
        for (int j = 0; j < 4; ++j) { const f32x4 gg = ((const GAS f32x4*)g)[lane + 64 * j], bb = ((const GAS f32x4*)b)[lane + 64 * j];
            v[j] = v[j] * rstd * gg + bb; }
        if (of32) { GAS f32x4* o = (GAS f32x4*)(of32 + (size_t)m * DM) + lane;
#pragma unroll
            for (int j = 0; j < 4; ++j) o[64 * j] = v[j]; }
        if (ob16) { GAS unsigned long long* o8 = (GAS unsigned long long*)(ob16 + (size_t)m * DM) + lane;
#pragma unroll
            for (int j = 0; j < 4; ++j) o8[64 * j] = (unsigned long long)pk2(v[j].x, v[j].y) | ((unsigned long long)pk2(v[j].z, v[j].w) << 32); }
    }
}

__device__ __forceinline__ void rope_phase(bf16* uR, const float2* TAB, int gtid, int NG) {
    for (int ch = gtid; ch < NTOK * 128; ch += NG) {
        const int m = ch >> 7, col = (ch & 127) * 8; int t, T; row_geom(m, t, T);
        const int j0 = (col & 127) >> 1;
        GAS v4u* p = (GAS v4u*)(uR + (size_t)m * RET_COLS + col);
        v4u w = *p;
        const float* tb = (const float*)(TAB + (size_t)t * 64 + j0);
        const float sc = col >= 512 ? 0.08838834764831845f : 1.0f;
        unsigned wv[4] = {w.x, w.y, w.z, w.w};
#pragma unroll
        for (int q = 0; q < 4; ++q) { const float cx = tb[2 * q], sx = tb[2 * q + 1]; const float x0 = bflo(wv[q]), x1 = bfhi(wv[q]);
            wv[q] = pk2((x0 * cx - x1 * sx) * sc, (x1 * cx + x0 * sx) * sc); }
        w.x = wv[0]; w.y = wv[1]; w.z = wv[2]; w.w = wv[3];
        *p = w;
    }
}

struct Args { const float* in[28]; float* out; unsigned char* ws; int ph_lo, ph_hi, li, pad; };
constexpr int N_PHASES = 15;

__global__ void __launch_bounds__(NWAVES * 64, 2) mk(Args args) {
    extern __shared__ __attribute__((aligned(16))) unsigned char lds[];
    LAS unsigned char* L = (LAS unsigned char*)lds;
    volatile LAS unsigned* MISC = (volatile LAS unsigned*)(L + MISC_OFF);
    const int tid = threadIdx.x, lane = tid & 63, wave = __builtin_amdgcn_readfirstlane(tid >> 6);
    const int G = gridDim.x; const int bx = blockIdx.x; const int vcu = (G % 8 == 0) ? (bx % 8) * (G / 8) + bx / 8 : bx;
    unsigned char* ws = args.ws; unsigned char* dout = (unsigned char*)args.out;
    gu32* ctl = (gu32*)(ws + WS_CTL);
    for (int u = tid; u < (LDS_BYTES - LDSCTL_OFF) / 4; u += NWAVES * 64) ((LAS unsigned*)(L + LDSCTL_OFF))[u] = 0u;
    __syncthreads();
    const int lo = args.ph_lo, hi = args.ph_hi;
    const bool use_bar = (hi - lo) > 1;
    XcdBarrier bar; bar.bar = (unsigned*)(ctl + CW_BAR) + args.li * XCD_BAR_WORDS; bar.x = 0; bar.st = nullptr;
    if (use_bar) bar = xcd_barrier_post((unsigned*)(ctl + CW_BAR) + args.li * XCD_BAR_WORDS, MISC + 8);
#define IN(k) (lo <= (k) && (k) < hi)
#define SEAM(k) do { if (IN(k) && IN((k) + 1)) xcd_barrier(bar); } while (0)
    const int gw = vcu * NWAVES + wave, NGW = G * NWAVES;
    const int gtid = vcu * (NWAVES * 64) + tid, NGT = G * NWAVES * 64;
    const float* xp = args.in[0]; const float* xs = args.in[1];
    bf16* W_UP1 = (bf16*)(ws + WS_W_UP1); bf16* W_DN1 = (bf16*)(ws + WS_W_DN1); bf16* W_IN = (bf16*)(ws + WS_W_IN);
    bf16* W_BR = (bf16*)(ws + WS_W_BR); bf16* W_OUT = (bf16*)(ws + WS_W_OUT); bf16* W_UP2 = (bf16*)(ws + WS_W_UP2); bf16* W_DN2 = (bf16*)(ws + WS_W_DN2);
    float2* TAB = (float2*)(ws + WS_TAB);
    bf16* XB = (bf16*)(dout + DO_XB); bf16* X1B = (bf16*)(ws + WS_X1B); bf16* X2B = (bf16*)(ws + WS_X2B);
    bf16* H1 = (bf16*)(ws + WS_H1); bf16* H2 = (bf16*)(ws + WS_H2);
    bf16* UR = (bf16*)(ws + WS_BIG); bf16* UA = (bf16*)(ws + WS_BIG); bf16* HB = (bf16*)(ws + WS_BIG);
    bf16* YA = (bf16*)(dout + DO_YA); bf16* YB = (bf16*)(dout + DO_YB);
    float* PF = args.out;

    if (IN(0)) {
        LAS float* scr = (LAS float*)(L + RING_OFF + wave * 16384);
        constexpr int I_UP = 16 * 176, I_DN = 44 * 32, I_IN = 16 * 184, I_BR = 8 * 32, I_OUT = 16 * 32;
        constexpr int NITEMS = 2 * I_UP + I_DN + I_IN + 2 * I_BR + 2 * I_OUT;
        for (int it = gw; it < NITEMS; it += NGW) {
            int r = it;
            if (r < I_UP) { p0_transpose_item(args.in[2], 2 * DFF, W_UP1, DM, 0, 0, 1, scr, r, lane); continue; } r -= I_UP;
            if (r < I_UP) { p0_transpose_item(args.in[24], 2 * DFF, W_UP2, DM, 0, 0, 1, scr, r, lane); continue; } r -= I_UP;
            if (r < I_DN) { p0_transpose_item(args.in[3], DM, W_DN1, DFF, 0, 0, 0, scr, r, lane); continue; } r -= I_DN;
            if (r < I_IN) { p0_transpose_item(args.in[6], IN_COLS, W_IN, DM, 0, 0, 0, scr, r, lane); continue; } r -= I_IN;
            if (r < I_BR) { p0_transpose_item(args.in[19], DM, W_BR, 512, 0, 0, 0, scr, r, lane); continue; } r -= I_BR;
            if (r < I_BR) { p0_transpose_item(args.in[20], DM, W_BR, 512, 0, 1024, 0, scr, r, lane); continue; } r -= I_BR;
            if (r < I_OUT) { p0_transpose_item(args.in[21], DM, W_OUT, 2048, 0, 0, 0, scr, r, lane); continue; } r -= I_OUT;
            p0_transpose_item(args.in[21], DM, W_OUT, 2048, 1024, 0, 0, scr, r, lane);
        }
        for (int m = gw; m < NTOK; m += NGW) {
            const float* xrow = (m < NTOK_P) ? xp + (size_t)m * DM : xs + (size_t)(m - NTOK_P) * DM;
            const GAS f32x4* xr = (const GAS f32x4*)xrow + lane; GAS unsigned long long* o8 = (GAS unsigned long long*)(XB + (size_t)m * DM) + lane;
#pragma unroll
            for (int j = 0; j < 4; ++j) { const f32x4 v = xr[64 * j]; o8[64 * j] = (unsigned long long)pk2(v.x, v.y) | ((unsigned long long)pk2(v.z, v.w) << 32); }
        }
        for (int e = gtid; e < 4096 * 64; e += NGT) {
            const int t = e >> 6, j = e & 63;
            const float ang = (float)(1.0 / pow(10000.0, (double)j / 63.0));
            const float th = (float)t * ang;
            TAB[e] = make_float2((float)cos((double)th), (float)sin((double)th));
        }
    }
    SEAM(0);
    if (IN(1)) { pg8::Gemm g{XB, W_UP1, NTOK, 2 * DFF, DM}; pg8::StaticOrder S; S.init(NTOK, 2 * DFF, G, bx);
        pg8::EpiSwiglu E{H1, DFF}; pg8::gemm_phase<pg8::EpiSwiglu, pg8::StaticOrder, true, true>(L + RING_OFF, g, S, E); }
    SEAM(1);
    if (IN(2)) { pg8::Gemm g{H1, W_DN1, NTOK, DM, DFF}; pg8::StaticOrder S; S.init(NTOK, DM, G, bx);
        pg8::EpiResidual<0> E{xp, xs, NTOK_P, nullptr, PF, DM, ALPHA, 0.5f}; pg8::gemm_phase<pg8::EpiResidual<0>, pg8::StaticOrder, true, true>(L + RING_OFF, g, S, E); }
    SEAM(2);
    if (IN(3)) ln_rows(PF, args.in[4], args.in[5], nullptr, X1B, gw, NGW, lane);
    SEAM(3);
    if (IN(4)) { pg8::Gemm g{X1B, W_IN + (size_t)RWKV_COLS * DM, NTOK, RET_COLS, DM}; pg8::StaticOrder S; S.init(NTOK, RET_COLS, G, bx);
        pg8::EpiStoreBf16 E{UR, RET_COLS}; pg8::gemm_phase<pg8::EpiStoreBf16, pg8::StaticOrder, true, true>(L + RING_OFF, g, S, E); }
    SEAM(4);
    if (IN(5)) rope_phase(UR, TAB, gtid, NGT);
    SEAM(5);
    if (IN(6)) { pg8::Gemm g{X1B, W_IN, NTOK, RWKV_COLS, DM}; pg8::StaticOrder S; S.init(NTOK, RWKV_COLS, G, bx);
        pg8::EpiStoreBf16 E{UA, RWKV_COLS}; pg8::gemm_phase<pg8::EpiStoreBf16, pg8::StaticOrder, true, true>(L + RING_OFF, g, S, E); }
    SEAM(6);
    if (IN(7)) {
        { pg8::Gemm g{YA, W_BR, NTOK, DM, 512}; pg8::StaticOrder S; S.init(NTOK, DM, G, bx);
          pg8::EpiStoreBf16 E{HB, 2048}; pg8::gemm_phase<pg8::EpiStoreBf16, pg8::StaticOrder, true, true>(L + RING_OFF, g, S, E); }
        { pg8::Gemm g{YB, W_BR + (size_t)1024 * 512, NTOK, DM, 512}; pg8::StaticOrder S; S.init(NTOK, DM, G, bx);
          pg8::EpiStoreBf16 E{HB + 1024, 2048}; pg8::gemm_phase<pg8::EpiStoreBf16, pg8::StaticOrder, true, true>(L + RING_OFF, g, S, E); }
    }
    SEAM(7);
    if (IN(8)) { pg8::Gemm g{X1B, W_IN + (size_t)(RWKV_COLS + RET_COLS) * DM, NTOK, GATE_COLS, DM}; pg8::StaticOrder S; S.init(NTOK, GATE_COLS, G, bx);
        pg8::EpiGateMul E{HB, 2048}; pg8::gemm_phase<pg8::EpiGateMul, pg8::StaticOrder, true, true>(L + RING_OFF, g, S, E); }
    SEAM(8);
    if (IN(9)) { pg8::Gemm g{HB, W_OUT, NTOK, DM, 2048}; pg8::StaticOrder S; S.init(NTOK, DM, G, bx);
        pg8::EpiResidual<1> E{nullptr, nullptr, 0, X1B, PF, DM, ALPHA, 1.0f}; pg8::gemm_phase<pg8::EpiResidual<1>, pg8::StaticOrder, true, true>(L + RING_OFF, g, S, E); }
    SEAM(9);
    if (IN(10)) ln_rows(PF, args.in[22], args.in[23], PF, X2B, gw, NGW, lane);
    SEAM(10);
    if (IN(11)) { pg8::Gemm g{X2B, W_UP2, NTOK, 2 * DFF, DM}; pg8::StaticOrder S; S.init(NTOK, 2 * DFF, G, bx);
        pg8::EpiSwiglu E{H2, DFF}; pg8::gemm_phase<pg8::EpiSwiglu, pg8::StaticOrder, true, true>(L + RING_OFF, g, S, E); }
    SEAM(11);
    if (IN(12)) { LAS float* scr = (LAS float*)(L + RING_OFF + wave * 16384);
        for (int it = gw; it < 44 * 32; it += NGW) p0_transpose_item(args.in[25], DM, W_DN2, DFF, 0, 0, 0, scr, it, lane); }
    SEAM(12);
    if (IN(13)) { pg8::Gemm g{H2, W_DN2, NTOK, DM, DFF}; pg8::StaticOrder S; S.init(NTOK, DM, G, bx);
        pg8::EpiResidual<0> E{PF, PF, NTOK, nullptr, PF, DM, ALPHA, 0.5f}; pg8::gemm_phase<pg8::EpiResidual<0>, pg8::StaticOrder, true, true>(L + RING_OFF, g, S, E); }
    SEAM(13);
    if (IN(14)) ln_rows(PF, args.in[26], args.in[27], PF, nullptr, gw, NGW, lane);
#undef IN
#undef SEAM
}

__device__ __forceinline__ float shifted(const bf16* UA, int m, int t, int T, int col, float mp, float mn) {
    const float u0 = bf2f(UA[(size_t)m * RWKV_COLS + col]);
    const float up = t > 0 ? bf2f(UA[(size_t)(m - 1) * RWKV_COLS + col]) : 0.f;
    const float un = t < T - 1 ? bf2f(UA[(size_t)(m + 1) * RWKV_COLS + col]) : 0.f;
    return u0 + mp * (up - u0) + mn * (un - u0);
}

__global__ void __launch_bounds__(64) naive_scan(const bf16* UA, const float* mu_p, const float* mu_n, const float* w0, const float* w2, const float* a0, const float* a2,
                                                 const float* k_k, const float* k_a, const float* r_k, bf16* YF, bf16* YBW, float* BONUS) {
    const int c = blockIdx.x, d = c / 96, rem = c % 96, s = rem / 8, h = rem % 8, lane = threadIdx.x;
    int row0, T; seq_geom(s, row0, T);
    __shared__ float sr[64], sw[64], sk[64], sa[64], sb[64], sxw[64], sxa[64];
    float S[64];
#pragma unroll
    for (int k = 0; k < 64; ++k) S[k] = 0.f;
    const int ch = h * 64 + lane, cr = ch, ck = 512 + ch, cv = 1024 + ch, cxw = 1536 + lane, cxa = 1600 + lane;
    const float mpr = mu_p[cr], mnr = mu_n[cr], mpk = mu_p[ck], mnk = mu_n[ck], mpv = mu_p[cv], mnv = mu_n[cv];
    const float mpw = mu_p[cxw], mnw = mu_n[cxw], mpa = mu_p[cxa], mna = mu_n[cxa];
    const float w0c = w0[d * 512 + ch], a0c = a0[d * 512 + ch], kkc = k_k[ch], kac = k_a[ch], rkc = r_k[ch];
    const float* w2d = w2 + (size_t)d * 64 * 512 + ch; const float* a2d = a2 + (size_t)d * 64 * 512 + ch;
    bf16* Y = d == 0 ? YF : YBW;
    for (int step = 0; step < T; ++step) {
        const int t = d ? (T - 1 - step) : step, m = row0 + t;
        const float r = shifted(UA, m, t, T, cr, mpr, mnr), k = shifted(UA, m, t, T, ck, mpk, mnk), v = shifted(UA, m, t, T, cv, mpv, mnv);
        const float xw = shifted(UA, m, t, T, cxw, mpw, mnw), xa = shifted(UA, m, t, T, cxa, mpa, mna);
        sxw[lane] = tanhf(xw); sxa[lane] = xa;
        __syncthreads();
        float zw = w0c, za = a0c;
#pragma unroll 8
        for (int j = 0; j < 64; ++j) { zw += sxw[j] * w2d[(size_t)j * 512]; za += sxa[j] * a2d[(size_t)j * 512]; }
        const float decay = __expf(-0.6065306597126334f * sigm(zw)), asig = sigm(za);
        const float kk0 = k * kkc; const float nrm = sqrtf(wave_sum(kk0 * kk0)); const float kk = kk0 / fmaxf(nrm, 1e-12f);
        const float kd = k * (1.0f + (asig - 1.0f) * kac);
        const float bon = wave_sum(r * kd * rkc);
        if (lane == 0) BONUS[(size_t)d * NTOK * 8 + (size_t)m * 8 + h] = bon;
        sr[lane] = r; sw[lane] = decay; sk[lane] = kd; sa[lane] = -kk; sb[lane] = kk * asig;
        __syncthreads();
        float sav = 0.f;
#pragma unroll
        for (int q = 0; q < 64; ++q) sav += S[q] * sa[q];
        float y = 0.f;
#pragma unroll
        for (int q = 0; q < 64; ++q) { S[q] = S[q] * sw[q] + sav * sb[q] + v * sk[q]; y += S[q] * sr[q]; }
        Y[(size_t)m * 512 + ch] = (bf16)f2bf(y);
        __syncthreads();
    }
}

__global__ void __launch_bounds__(64) naive_post(const bf16* UA, const float* mu_p, const float* mu_n, const float* g2, const float* lnx_g, const float* lnx_b,
                                                 const bf16* YF, const bf16* YBW, const float* BONUS, bf16* YA) {
    const int m = blockIdx.x >> 3, h = blockIdx.x & 7, lane = threadIdx.x, ch = h * 64 + lane;
    int t, T; row_geom(m, t, T);
    __shared__ float sg[128];
#pragma unroll
    for (int q = 0; q < 2; ++q) { const int col = 1664 + lane + 64 * q; sg[lane + 64 * q] = sigm(shifted(UA, m, t, T, col, mu_p[col], mu_n[col])); }
    __syncthreads();
    float g = 0.f;
#pragma unroll 8
    for (int j = 0; j < 128; ++j) g += sg[j] * g2[(size_t)j * 512 + ch];
    const float y = bf2f(YF[(size_t)m * 512 + ch]) + bf2f(YBW[(size_t)m * 512 + ch]);
    const float mean = wave_sum(y) * (1.f / 64.f); const float dv = y - mean; const float var = wave_sum(dv * dv) * (1.f / 64.f);
    const float yn = dv * (1.0f / sqrtf(var + 64e-5f)) * lnx_g[ch] + lnx_b[ch];
    const float bonus = BONUS[(size_t)m * 8 + h] + BONUS[(size_t)NTOK * 8 + (size_t)m * 8 + h];
    const float v = shifted(UA, m, t, T, 1024 + ch, mu_p[1024 + ch], mu_n[1024 + ch]);
    YA[(size_t)m * 512 + ch] = (bf16)f2bf((yn + bonus * v) * g);
}

__global__ void __launch_bounds__(256) naive_ret(const bf16* UR, bf16* YBo) {
    const int pidx = blockIdx.x >> 2, h = blockIdx.x & 3, tid = threadIdx.x, m0 = 2 * pidx;
    int t0, T; row_geom(m0, t0, T); const int row0 = m0 - t0;
    __shared__ float sc[2][4096]; __shared__ float qs[2][128]; __shared__ float red[4];
    { const int qi = tid >> 7, dd = tid & 127; qs[qi][dd] = bf2f(UR[(size_t)(m0 + qi) * RET_COLS + h * 128 + dd]); }
    __syncthreads();
    const float lg = log2f(1.0f - exp2f(-5.0f - (float)h));
    for (int j = tid; j < T; j += 256) {
        const v4u* kr = (const v4u*)(UR + (size_t)(row0 + j) * RET_COLS + 512 + h * 128);
        float d0 = 0.f, d1 = 0.f;
#pragma unroll 4
        for (int c8 = 0; c8 < 16; ++c8) { const v4u w = kr[c8]; const unsigned wv[4] = {w.x, w.y, w.z, w.w};
#pragma unroll
            for (int q = 0; q < 4; ++q) { const float k0 = bflo(wv[q]), k1 = bfhi(wv[q]); const int dd = c8 * 8 + q * 2;
                d0 += k0 * qs[0][dd] + k1 * qs[0][dd + 1]; d1 += k0 * qs[1][dd] + k1 * qs[1][dd + 1]; } }
        sc[0][j] = d0 * exp2f(lg * fabsf((float)(t0 - j))); sc[1][j] = d1 * exp2f(lg * fabsf((float)(t0 + 1 - j)));
    }
    __syncthreads();
    const int qi = tid >> 7, e = tid & 127;
    float o = 0.f;
    const bf16* vcol = UR + (size_t)row0 * RET_COLS + 1024 + h * 128 + e;
    for (int j = 0; j < T; ++j) o += sc[qi][j] * bf2f(vcol[(size_t)j * RET_COLS]);
    float sm = wave_sum(o); if ((tid & 63) == 0) red[tid >> 6] = sm;
    __syncthreads();
    const float mean = (red[2 * qi] + red[2 * qi + 1]) * (1.f / 128.f);
    __syncthreads();
    const float dv = o - mean; float sq = wave_sum(dv * dv); if ((tid & 63) == 0) red[tid >> 6] = sq;
    __syncthreads();
    const float var = (red[2 * qi] + red[2 * qi + 1]) * (1.f / 128.f);
    const float gt = bf2f(UR[(size_t)(m0 + qi) * RET_COLS + 1536 + h * 128 + e]);
    const float sil = gt / (1.0f + __expf(-gt));
    YBo[(size_t)(m0 + qi) * 512 + h * 128 + e] = (bf16)f2bf(sil * dv * (1.0f / sqrtf(var + 1e-6f)));
}

#ifndef MK_FUSE
#define MK_FUSE 0
#endif
extern "C" void kernel_launch(void* const* d_in, const int* in_sizes, int n_in, void* d_out, int out_size, void* d_ws, size_t ws_size, hipStream_t stream) {
    static int grid = 0;
    if (grid == 0) {
        if (n_in != 28 || out_size != NTOK * DM || ws_size < WS_END) { fprintf(stderr, "kernel_launch: unexpected problem (n_in %d, out %d, ws %zu); nothing launched\n", n_in, out_size, ws_size); grid = -1; return; }
        int dev = 0, cus = 0, per_cu = 0;
        if (hipGetDevice(&dev) != hipSuccess || hipDeviceGetAttribute(&cus, hipDeviceAttributeMultiprocessorCount, dev) != hipSuccess) { grid = -1; return; }
        if (hipFuncSetAttribute((const void*)mk, hipFuncAttributeMaxDynamicSharedMemorySize, LDS_BYTES) != hipSuccess) { fprintf(stderr, "kernel_launch: hipFuncSetAttribute failed\n"); grid = -1; return; }
        if (hipOccupancyMaxActiveBlocksPerMultiprocessor(&per_cu, (const void*)mk, NWAVES * 64, LDS_BYTES) != hipSuccess || per_cu < 1) { fprintf(stderr, "kernel_launch: occupancy query says %d blocks per CU\n", per_cu); }
        (void)hipGetLastError();
        grid = cus;
    }
    if (grid < 0) return;
    (void)hipMemsetAsync((char*)d_ws + WS_CTL, 0, CTL_ZERO_BYTES, stream);
    Args a{};
    for (int i = 0; i < 28; ++i) a.in[i] = (const float*)d_in[i];
    a.out = (float*)d_out; a.ws = (unsigned char*)d_ws;
    unsigned char* ws = (unsigned char*)d_ws; unsigned char* dout = (unsigned char*)d_out;
    int li = 0;
    auto run = [&](int lo, int hi) {
#if MK_FUSE
        a.ph_lo = lo; a.ph_hi = hi; a.li = li++; hipLaunchKernelGGL(mk, dim3(grid), dim3(NWAVES * 64), LDS_BYTES, stream, a);
#else
        for (int k = lo; k < hi; ++k) { a.ph_lo = k; a.ph_hi = k + 1; a.li = 0; hipLaunchKernelGGL(mk, dim3(grid), dim3(NWAVES * 64), LDS_BYTES, stream, a); }
#endif
    };
    const bf16* UR = (const bf16*)(ws + WS_BIG); const bf16* UA = (const bf16*)(ws + WS_BIG);
    bf16* YF = (bf16*)(dout + DO_YF); bf16* YBW = (bf16*)(dout + DO_YBW); bf16* YB = (bf16*)(dout + DO_YB); bf16* YA = (bf16*)(dout + DO_YA);
    float* BONUS = (float*)(ws + WS_BONUS);
    run(0, 6);
    hipLaunchKernelGGL(naive_ret, dim3((NTOK / 2) * 4), dim3(256), 0, stream, UR, YB);
    run(6, 7);
    hipLaunchKernelGGL(naive_scan, dim3(192), dim3(64), 0, stream, UA, a.in[7], a.in[8], a.in[9], a.in[10], a.in[11], a.in[12], a.in[14], a.in[15], a.in[16], YF, YBW, BONUS);
    hipLaunchKernelGGL(naive_post, dim3(NTOK * 8), dim3(64), 0, stream, UA, a.in[7], a.in[8], a.in[13], a.in[17], a.in[18], (const bf16*)YF, (const bf16*)YBW, (const float*)BONUS, YA);
    run(7, N_PHASES);
}
```

```cpp
#include <hip/hip_runtime.h>
#include <cstdio>
#include <cstdint>
#include <cmath>
namespace pg8 {
#define PG8_LAS __attribute__((address_space(3)))
typedef unsigned short bf16_t;
typedef short bf16x8 __attribute__((ext_vector_type(8)));
typedef float f32x4 __attribute__((ext_vector_type(4)));
typedef unsigned u32x4 __attribute__((ext_vector_type(4)));
constexpr int BM = 256, BK = 64, HALF = 128, HTB = HALF * BK * 2  , STAGE_BYTES = 8 * HTB, NXCD = 8, WGM = 8;

__host__ __device__ __forceinline__ int lds_byte(int r, int c) { const int st = (r >> 4) * 2 + (c >> 5), rr = r & 15, cc = c & 31, ob = rr * 64 + cc * 2; return st * 1024 + (ob ^ (((ob >> 9) & 1) << 5)); }
__host__ __device__ __forceinline__ void stage_rc(int b, int& R, int& C) { const int st = b / 1024, sb = b % 1024, swz = sb ^ (((sb >> 9) & 1) << 5); R = (st >> 1) * 16 + swz / 64; C = (st & 1) * 32 + (swz % 64) / 2; }
__host__ __device__ __forceinline__ int perm32(int rho) { const int n = rho >> 4, i = rho & 15; return 8 * (i >> 2) + 4 * n + (i & 3); }

struct Unit { int pm, pn; };
struct Gemm { const bf16_t* A; const bf16_t* Bt; int M, N, K; };

struct StaticOrder {
    int nM, nN, nwg, G, c;
    __host__ __device__ void init(int M, int N, int G_, int c_) { nM = M / BM; nN = N / BM; nwg = nM * nN; G = G_; c = c_; }
    __host__ __device__ bool next(int i, Unit& u) const {
        const long L = (long)i * G + c; if (L >= nwg) return false;
        int wgid = (int)L; { const int q = nwg / NXCD, r = nwg % NXCD, xcd = wgid % NXCD, off = wgid / NXCD; wgid = (xcd < r ? xcd * (q + 1) : r * (q + 1) + (xcd - r) * q) + off; }
        const int nig = WGM * nN, gid = wgid / nig, fm = gid * WGM, gsz = (nM - fm) < WGM ? (nM - fm) : WGM;
        u.pm = fm + ((wgid % nig) % gsz); u.pn = (wgid % nig) / gsz; return true;
    }
    __device__ __forceinline__ void a_ready(const Unit&) const {}
    __device__ __forceinline__ void done(const Unit&) const {}
};

__device__ __forceinline__ unsigned cvt_pk_bf16(float lo, float hi) { unsigned r; asm volatile("v_cvt_pk_bf16_f32 %0, %1, %2" : "=v"(r) : "v"(lo), "v"(hi)); return r; }
typedef float f32x2 __attribute__((ext_vector_type(2)));
__device__ __forceinline__ float sigmoidf_fast(float x) { return __builtin_amdgcn_rcpf(1.0f + __builtin_amdgcn_exp2f(-1.4426950408889634f * x)); }
__device__ __forceinline__ float siluf_fast(float x) { return x * sigmoidf_fast(x); }
__device__ __forceinline__ float bf16_lo(unsigned w) { return __uint_as_float(w << 16); }
__device__ __forceinline__ float bf16_hi(unsigned w) { return __uint_as_float(w & 0xffff0000u); }

struct EpiStoreBf16 {
    static constexpr bool PERM = true, AFTER_DRAIN = false;
    bf16_t* O; int ldc;
    __device__ __forceinline__ void operator()(const f32x4 (&acc)[2][2][4][2], const Unit& u, int wr, int wc, int fr, int fq) const {
        const int row0 = u.pm * BM + wr * 64 + fr, col0 = u.pn * BM + wc * 32 + 8 * fq;
#pragma unroll
        for (int ai = 0; ai < 2; ++ai)
#pragma unroll
            for (int m = 0; m < 4; ++m) { bf16_t* rowp = O + (size_t)(row0 + ai * HALF + m * 16) * ldc + col0;
#pragma unroll
                for (int bj = 0; bj < 2; ++bj) { const f32x4 v0 = acc[ai][bj][m][0], v1 = acc[ai][bj][m][1];
                    u32x4 w; w.x = cvt_pk_bf16(v0[0], v0[1]); w.y = cvt_pk_bf16(v0[2], v0[3]); w.z = cvt_pk_bf16(v1[0], v1[1]); w.w = cvt_pk_bf16(v1[2], v1[3]);
                    *(u32x4*)(rowp + bj * HALF) = w; } }
    }
};
struct EpiSwiglu {
    static constexpr bool PERM = true, AFTER_DRAIN = false;
    bf16_t* H; int ldh;
    __device__ __forceinline__ void operator()(const f32x4 (&acc)[2][2][4][2], const Unit& u, int wr, int wc, int fr, int fq) const {
        const int row0 = u.pm * BM + wr * 64 + fr, col0 = u.pn * HALF + wc * 32 + 8 * fq;
#pragma unroll
        for (int ai = 0; ai < 2; ++ai)
#pragma unroll
            for (int m = 0; m < 4; ++m) { bf16_t* rowp = H + (size_t)(row0 + ai * HALF + m * 16) * ldh + col0;
                const f32x4 g0 = acc[ai][0][m][0], g1 = acc[ai][0][m][1], u0 = acc[ai][1][m][0], u1 = acc[ai][1][m][1];
                float h[8];
#pragma unroll
                for (int i = 0; i < 4; ++i) { h[i] = siluf_fast(g0[i]) * u0[i]; h[4 + i] = siluf_fast(g1[i]) * u1[i]; }
                u32x4 w; w.x = cvt_pk_bf16(h[0], h[1]); w.y = cvt_pk_bf16(h[2], h[3]); w.z = cvt_pk_bf16(h[4], h[5]); w.w = cvt_pk_bf16(h[6], h[7]);
                *(u32x4*)rowp = w; }
    }
};
struct EpiGateMul {
    static constexpr bool PERM = true, AFTER_DRAIN = false;
    bf16_t* HB; int ldc;
    __device__ __forceinline__ void operator()(const f32x4 (&acc)[2][2][4][2], const Unit& u, int wr, int wc, int fr, int fq) const {
        const int row0 = u.pm * BM + wr * 64 + fr, col0 = u.pn * BM + wc * 32 + 8 * fq;
#pragma unroll
        for (int ai = 0; ai < 2; ++ai)
#pragma unroll
            for (int m = 0; m < 4; ++m) { bf16_t* rowp = HB + (size_t)(row0 + ai * HALF + m * 16) * ldc + col0;
#pragma unroll
                for (int bj = 0; bj < 2; ++bj) { const f32x4 v0 = acc[ai][bj][m][0], v1 = acc[ai][bj][m][1];
                    const u32x4 hb = *(const u32x4*)(rowp + bj * HALF);
                    u32x4 w;
                    w.x = cvt_pk_bf16(sigmoidf_fast(v0[0]) * bf16_lo(hb.x), sigmoidf_fast(v0[1]) * bf16_hi(hb.x));
                    w.y = cvt_pk_bf16(sigmoidf_fast(v0[2]) * bf16_lo(hb.y), sigmoidf_fast(v0[3]) * bf16_hi(hb.y));
                    w.z = cvt_pk_bf16(sigmoidf_fast(v1[0]) * bf16_lo(hb.z), sigmoidf_fast(v1[1]) * bf16_hi(hb.z));
                    w.w = cvt_pk_bf16(sigmoidf_fast(v1[2]) * bf16_lo(hb.w), sigmoidf_fast(v1[3]) * bf16_hi(hb.w));
                    *(u32x4*)(rowp + bj * HALF) = w; } }
    }
};
template <int RES> struct EpiResidual {
    static constexpr bool PERM = false, AFTER_DRAIN = false;
    const float* r0; const float* r1; int split; const bf16_t* rb; float* out; int ldc; float alpha, scale;
    __device__ __forceinline__ void operator()(const f32x4 (&acc)[2][2][4][2], const Unit& u, int wr, int wc, int fr, int fq) const {
        const int row0 = u.pm * BM + wr * 64 + fr, col0 = u.pn * BM + wc * 32 + 4 * fq;
#pragma unroll
        for (int ai = 0; ai < 2; ++ai)
#pragma unroll
            for (int m = 0; m < 4; ++m) { const int row = row0 + ai * HALF + m * 16;
                const float* resf = (row < split) ? r0 + (size_t)row * ldc : r1 + (size_t)(row - split) * ldc;
#pragma unroll
                for (int bj = 0; bj < 2; ++bj)
#pragma unroll
                    for (int n = 0; n < 2; ++n) { const int c = col0 + bj * HALF + n * 16; f32x4 rv;
                        if (RES == 0) rv = *(const f32x4*)(resf + c);
                        else { const unsigned long long w = *(const unsigned long long*)(rb + (size_t)row * ldc + c); const unsigned lo = (unsigned)w, hi = (unsigned)(w >> 32);
                            rv = (f32x4){bf16_lo(lo), bf16_hi(lo), bf16_lo(hi), bf16_hi(hi)}; }
                        *(f32x4*)(out + (size_t)row * ldc + c) = rv * alpha + acc[ai][bj][m][n] * scale; } }
    }
};

template <class Epi, class Sched, bool ALIGN_EPI = false, bool SP2 = false>
__device__ __forceinline__ void gemm_phase(PG8_LAS unsigned char* lds, const Gemm g, const Sched& S, const Epi& E) {
    const int tid = threadIdx.x, wid = __builtin_amdgcn_readfirstlane(tid >> 6), lane = tid & 63, wr = wid >> 2, wc = wid & 3, fr = lane & 15, fq = lane >> 4;
    const int K = g.K, nt = K / BK;
    unsigned voffA[2], voffB[2];
#pragma unroll
    for (int i = 0; i < 2; ++i) { int R, C; stage_rc(tid * 16 + i * 8192, R, C); const int Rb = Epi::PERM ? ((R & ~31) + perm32(R & 31)) : R;
        voffA[i] = (unsigned)(R * K + C) * 2u; voffB[i] = (unsigned)(Rb * K + C) * 2u; }
    const size_t kstep = (size_t)(BK * 2);
    const size_t hstep = (size_t)HALF * K * 2;
    const size_t tstep = 2 * hstep;
    const unsigned ldsw = (unsigned)wid * 1024u;
    const int aoff = lds_byte(wr * 64 + fr, fq * 8), boff = lds_byte(wc * 32 + fr, fq * 8);
#define PG8_SA(b, h) (((b) * 2 + (h)) * HTB)
#define PG8_SB(b, h) ((4 + (b) * 2 + (h)) * HTB)
#define PG8_STAGE(bufoff, gbase, voff) do { _Pragma("unroll") for (int _i = 0; _i < 2; ++_i) \
        __builtin_amdgcn_global_load_lds((const unsigned*)((const char*)(gbase) + (voff)[_i]), (PG8_LAS unsigned*)(lds + (bufoff) + ldsw + _i * 8192), 16, 0, 0); } while (0)
#define PG8_LDA(dst, b, h) do { _Pragma("unroll") for (int m = 0; m < 4; ++m) _Pragma("unroll") for (int k = 0; k < 2; ++k) dst[m][k] = *(const PG8_LAS bf16x8*)(lds + PG8_SA(b, h) + aoff + m * 2048 + k * 1024); } while (0)
#define PG8_LDB(dst, b, h) do { _Pragma("unroll") for (int n = 0; n < 2; ++n) _Pragma("unroll") for (int k = 0; k < 2; ++k) dst[n][k] = *(const PG8_LAS bf16x8*)(lds + PG8_SB(b, h) + boff + n * 2048 + k * 1024); } while (0)
#define PG8_MMA(ai, bj, At, Bt) do { __builtin_amdgcn_s_setprio(1); _Pragma("unroll") for (int m = 0; m < 4; ++m) _Pragma("unroll") for (int n = 0; n < 2; ++n) _Pragma("unroll") for (int k = 0; k < 2; ++k) \
        acc[ai][bj][m][n] = __builtin_amdgcn_mfma_f32_16x16x32_bf16(Bt[n][k], At[m][k], acc[ai][bj][m][n], 0, 0, 0); __builtin_amdgcn_s_setprio(0); } while (0)
#define PG8_WAIT_V(n) asm volatile("s_waitcnt vmcnt(" #n ")" ::: "memory")
#define PG8_WAIT_L(n) asm volatile("s_waitcnt lgkmcnt(" #n ")" ::: "memory")
#define PG8_BAR __builtin_amdgcn_s_barrier()
#define PG8_SCHED __builtin_amdgcn_sched_barrier(0)
    Unit cur, nxt; int ui = 0;
    if (!S.next(0, cur)) return;
    f32x4 acc[2][2][4][2];
#pragma unroll
    for (int a = 0; a < 2; ++a)
#pragma unroll
        for (int b = 0; b < 2; ++b)
#pragma unroll
            for (int m = 0; m < 4; ++m)
#pragma unroll
                for (int n = 0; n < 2; ++n) acc[a][b][m][n] = (f32x4){0.f, 0.f, 0.f, 0.f};
    bf16x8 At[4][2], B0[2][2], B1[2][2];
    const char* cA = (const char*)g.A + (size_t)cur.pm * tstep; const char* cB = (const char*)g.Bt + (size_t)cur.pn * tstep;
    S.a_ready(cur);
    if constexpr (SP2) {
        PG8_STAGE(PG8_SB(0, 0), cB, voffB); PG8_STAGE(PG8_SB(0, 1), cB + hstep, voffB); PG8_STAGE(PG8_SA(0, 0), cA, voffA); PG8_STAGE(PG8_SA(0, 1), cA + hstep, voffA);
        if (wr == 1) PG8_BAR;
        PG8_WAIT_V(2); PG8_BAR;
        PG8_STAGE(PG8_SB(1, 0), cB + kstep, voffB); PG8_STAGE(PG8_SA(1, 0), cA + kstep, voffA); PG8_STAGE(PG8_SB(1, 1), cB + hstep + kstep, voffB);
        PG8_WAIT_V(6); PG8_BAR;
    } else {
        PG8_STAGE(PG8_SB(0, 0), cB, voffB); PG8_STAGE(PG8_SA(0, 0), cA, voffA); PG8_STAGE(PG8_SB(0, 1), cB + hstep, voffB); PG8_STAGE(PG8_SA(0, 1), cA + hstep, voffA);
        if (wr == 1) PG8_BAR;
        PG8_WAIT_V(4); PG8_BAR;
        PG8_STAGE(PG8_SB(1, 0), cB + kstep, voffB); PG8_STAGE(PG8_SA(1, 0), cA + kstep, voffA); PG8_STAGE(PG8_SB(1, 1), cB + hstep + kstep, voffB);
        PG8_WAIT_V(6); PG8_BAR;
    }
    for (;;) {
        const bool has_next = S.next(ui + 1, nxt);
        const char* nA = has_next ? (const char*)g.A + (size_t)nxt.pm * tstep : cA; const char* nB = has_next ? (const char*)g.Bt + (size_t)nxt.pn * tstep : cB;
        for (int t = 0; t < nt; t += 2) {
            const bool last = (t == nt - 2);
            const char* a1 = cA + (size_t)(t + 1) * kstep;
            const char* a2 = last ? nA : cA + (size_t)(t + 2) * kstep; const char* b2 = last ? nB : cB + (size_t)(t + 2) * kstep;
            const char* a3 = a2 + kstep; const char* b3 = b2 + kstep;
            if (last && has_next) S.a_ready(nxt);
            if constexpr (SP2) {
            PG8_LDB(B0, 0, 0); PG8_LDB(B1, 0, 1); PG8_SCHED; PG8_LDA(At, 0, 0); PG8_STAGE(PG8_SA(1, 1), a1 + hstep, voffA);
            PG8_WAIT_V(8); PG8_WAIT_L(0); PG8_BAR; PG8_MMA(0, 0, At, B0); PG8_MMA(0, 1, At, B1); PG8_BAR; PG8_SCHED;
            PG8_LDA(At, 0, 1); PG8_STAGE(PG8_SB(0, 0), b2, voffB); PG8_STAGE(PG8_SB(0, 1), b2 + hstep, voffB); PG8_STAGE(PG8_SA(0, 0), a2, voffA);
            PG8_WAIT_V(8); PG8_WAIT_L(0); PG8_BAR; PG8_MMA(1, 0, At, B0); PG8_MMA(1, 1, At, B1); PG8_BAR; PG8_SCHED;
            PG8_LDB(B0, 1, 0); PG8_LDB(B1, 1, 1); PG8_SCHED; PG8_LDA(At, 1, 0); PG8_STAGE(PG8_SA(0, 1), a2 + hstep, voffA);
            PG8_WAIT_V(8); PG8_WAIT_L(0); PG8_BAR; PG8_MMA(0, 0, At, B0); PG8_MMA(0, 1, At, B1); PG8_BAR; PG8_SCHED;
            PG8_LDA(At, 1, 1); PG8_STAGE(PG8_SB(1, 0), b3, voffB); PG8_STAGE(PG8_SB(1, 1), b3 + hstep, voffB); PG8_STAGE(PG8_SA(1, 0), a3, voffA);
            PG8_WAIT_V(8); PG8_WAIT_L(0); PG8_BAR; PG8_MMA(1, 0, At, B0); PG8_MMA(1, 1, At, B1); PG8_BAR; PG8_SCHED;
            } else {
            PG8_LDB(B0, 0, 0); PG8_SCHED; PG8_LDA(At, 0, 0); PG8_STAGE(PG8_SA(1, 1), a1 + hstep, voffA);
            PG8_WAIT_L(8); PG8_BAR; PG8_WAIT_L(0); PG8_MMA(0, 0, At, B0); PG8_BAR; PG8_SCHED;
            PG8_LDB(B1, 0, 1); PG8_STAGE(PG8_SB(0, 0), b2, voffB);
            PG8_BAR; PG8_WAIT_L(0); PG8_MMA(0, 1, At, B1); PG8_BAR;
            PG8_LDA(At, 0, 1); PG8_STAGE(PG8_SA(0, 0), a2, voffA);
            PG8_BAR; PG8_WAIT_L(0); PG8_MMA(1, 0, At, B0); PG8_BAR; PG8_SCHED;
            PG8_STAGE(PG8_SB(0, 1), b2 + hstep, voffB);
            PG8_WAIT_V(6); PG8_BAR; PG8_MMA(1, 1, At, B1); PG8_BAR;
            PG8_LDB(B0, 1, 0); PG8_SCHED; PG8_LDA(At, 1, 0); PG8_STAGE(PG8_SA(0, 1), a2 + hstep, voffA);
            PG8_WAIT_L(8); PG8_BAR; PG8_WAIT_L(0); PG8_MMA(0, 0, At, B0); PG8_BAR; PG8_SCHED;
            PG8_LDB(B1, 1, 1); PG8_STAGE(PG8_SB(1, 0), b3, voffB);
            PG8_BAR; PG8_WAIT_L(0); PG8_MMA(0, 1, At, B1); PG8_BAR;
            PG8_LDA(At, 1, 1); PG8_STAGE(PG8_SA(1, 0), a3, voffA);
            PG8_BAR; PG8_WAIT_L(0); PG8_MMA(1, 0, At, B0); PG8_BAR; PG8_SCHED;
            PG8_STAGE(PG8_SB(1, 1), b3 + hstep, voffB);
            PG8_WAIT_V(6); PG8_BAR; PG8_MMA(1, 1, At, B1); PG8_BAR;
            }
        }
        if constexpr (ALIGN_EPI) { if (wr == 0) PG8_BAR; }
        if constexpr (!Epi::AFTER_DRAIN) { E(acc, cur, wr, wc, fr, fq); S.done(cur); }
        if (!has_next) break;
#pragma unroll
        for (int a = 0; a < 2; ++a)
#pragma unroll
            for (int b = 0; b < 2; ++b)
#pragma unroll
                for (int m = 0; m < 4; ++m)
#pragma unroll
                    for (int n = 0; n < 2; ++n) acc[a][b][m][n] = (f32x4){0.f, 0.f, 0.f, 0.f};
        cur = nxt; cA = nA; cB = nB; ++ui;
        if constexpr (ALIGN_EPI) { if (wr == 1) PG8_BAR; }
    }
    PG8_WAIT_V(0);
    if constexpr (!ALIGN_EPI) { if (wr == 0) PG8_BAR; }
    PG8_BAR;
    if constexpr (Epi::AFTER_DRAIN) { E.fused(acc, cur, wr, wc, fr, fq, lds, wid, lane); S.done(cur); }
#undef PG8_SA
#undef PG8_SB
#undef PG8_STAGE
#undef PG8_LDA
#undef PG8_LDB
#undef PG8_MMA
#undef PG8_WAIT_V
#undef PG8_WAIT_L
#undef PG8_BAR
#undef PG8_SCHED
}
}

constexpr int NWAVES = 8;
constexpr int NTOK = 32768, NTOK_P = 16384, DM = 1024, DFF = 2816;
constexpr int RWKV_COLS = 1792, RET_COLS = 2048, GATE_COLS = 2048, IN_COLS = 5888;
constexpr float ALPHA = 1.189207115002721f, LN_EPS = 1e-5f;
constexpr size_t MiB = 1u << 20;
constexpr size_t WS_CTL = 0, CTL_ZERO_BYTES = 1 * MiB;
constexpr size_t WS_W_UP2 = 1 * MiB;
constexpr size_t WS_W_DN2 = 1 * MiB;
constexpr size_t WS_W_UP1 = 12 * MiB;
constexpr size_t WS_W_DN1 = 23 * MiB;
constexpr size_t WS_W_IN = 29 * MiB;
constexpr size_t WS_G2T = 40 * MiB + 512 * 1024;
constexpr size_t WS_W_BR = 41 * MiB;
constexpr size_t WS_W_OUT = 43 * MiB;
constexpr size_t WS_TAB = 47 * MiB;
constexpr size_t WS_X1B = 49 * MiB;
constexpr size_t WS_BIG = 113 * MiB;
constexpr size_t WS_BONUS = 242 * MiB;
constexpr size_t WS_H1 = 49 * MiB;
constexpr size_t WS_X2B = 12 * MiB;
constexpr size_t WS_H2 = 76 * MiB;
constexpr size_t WS_END = 256 * MiB;
constexpr size_t DO_XB = 0;
constexpr size_t DO_KV = 0;
constexpr size_t DO_YF = 0, DO_YBW = 32 * MiB;
constexpr size_t DO_YB = 64 * MiB;
constexpr size_t DO_YA = 96 * MiB;
constexpr int CW_BAR = 4096;
constexpr int RING_OFF = 0, RING_BYTES = 131072;
constexpr int LDSCTL_OFF = RING_BYTES, MISC_OFF = LDSCTL_OFF + 320;
constexpr int LDS_BYTES = 147456;
#define GAS __attribute__((address_space(1)))
#define LAS __attribute__((address_space(3)))
typedef unsigned short bf16;
typedef unsigned v4u __attribute__((ext_vector_type(4)));
typedef float f32x4 __attribute__((ext_vector_type(4)));
typedef short bf16x8 __attribute__((ext_vector_type(8)));
typedef GAS unsigned gu32;
typedef GAS unsigned long long gu64;
#define RLX_AGENT __ATOMIC_RELAXED, __HIP_MEMORY_SCOPE_AGENT
#define LDS_WAIT() asm volatile("s_waitcnt lgkmcnt(0)" ::: "memory")
#define VM_WAIT() asm volatile("s_waitcnt vmcnt(0)" ::: "memory")
__device__ __forceinline__ unsigned long long rt() { return __builtin_amdgcn_s_memrealtime(); }
__device__ __forceinline__ unsigned f2bf(float f) { unsigned u = __builtin_bit_cast(unsigned, f); return (u + 0x7fffu + ((u >> 16) & 1u)) >> 16; }
__device__ __forceinline__ unsigned pk2(float lo, float hi) { return f2bf(lo) | (f2bf(hi) << 16); }

#define XB_TMO      128
#define XB_XCNT(j)  (256  + 64 * (j))
#define XB_XSUB(j)  (1280 + 64 * (j))
#define XB_XGEN(j)  (2304 + 64 * (j))
#define XB_TOP      3328
#define XB_TOPGEN   3392
#define XCD_BAR_WORDS 3456
#define XB_SPIN_CAP (1u << 18)

__device__ __forceinline__ unsigned xb_ld(unsigned* p)              { return __hip_atomic_load(p, __ATOMIC_RELAXED, __HIP_MEMORY_SCOPE_AGENT); }
__device__ __forceinline__ unsigned xb_add(unsigned* p, unsigned v) { return __hip_atomic_fetch_add(p, v, __ATOMIC_RELAXED, __HIP_MEMORY_SCOPE_AGENT); }
__device__ __forceinline__ unsigned xb_xcc_id() { return (unsigned)__builtin_amdgcn_s_getreg((3 << 11) | 20) & 0xFu; }
#define XB_SPIN(cond, bar) do { unsigned _sp = 0; while (cond) { __builtin_amdgcn_s_sleep(1); \
    if ((++_sp & 255u) == 0u) { if (xb_ld(&(bar)[XB_TMO])) break; if (_sp > XB_SPIN_CAP) { atomicAdd(&(bar)[XB_TMO], 1u); break; } } } } while (0)

struct XcdBarrier {
    unsigned* bar; unsigned x;
    volatile LAS unsigned* st;
};

__device__ __forceinline__ XcdBarrier xcd_barrier_post(unsigned* bar, volatile LAS unsigned* st) {
    XcdBarrier b; b.bar = bar; b.x = xb_xcc_id(); b.st = st;
    if (threadIdx.x == 0) (void)xb_add(&bar[XB_XCNT(b.x)], 1u);
    return b;
}
__device__ __forceinline__ void xcd_barrier_complete(unsigned* bar, unsigned x, unsigned& nloc, unsigned& nx) {
    const unsigned G = gridDim.x * gridDim.y * gridDim.z;
    unsigned sum, cnt, mine, sp = 0u;
    for (;;) {
        sum = 0u; cnt = 0u; mine = 0u;
#pragma unroll
        for (unsigned j = 0; j < 16; ++j) { const unsigned c = xb_ld(&bar[XB_XCNT(j)]); sum += c; cnt += (c > 0u) ? 1u : 0u; mine = (j == x) ? c : mine; }
        if (sum == G) break;
        __builtin_amdgcn_s_sleep(1);
        if ((++sp & 255u) == 0u) { if (xb_ld(&bar[XB_TMO])) break; if (sp > XB_SPIN_CAP) { atomicAdd(&bar[XB_TMO], 1u); break; } }
    }
    nloc = mine > 0u ? mine : 1u; nx = cnt > 0u ? cnt : 1u;
}

__device__ __forceinline__ void xcd_barrier(const XcdBarrier& b) {
    asm volatile("s_waitcnt vmcnt(0)" ::: "memory");
    __syncthreads();
    if (threadIdx.x == 0) {
        unsigned* bar = b.bar;
        __builtin_amdgcn_s_waitcnt(0);
        unsigned nloc = b.st[0], nx = b.st[1];
        if (nloc == 0u) { xcd_barrier_complete(bar, b.x, nloc, nx); b.st[0] = nloc; b.st[1] = nx; }
        const unsigned old = xb_add(&bar[XB_XSUB(b.x)], 1u);
        const unsigned gen = old / nloc;
        if (old + 1u == (gen + 1u) * nloc) {
            __builtin_amdgcn_fence(__ATOMIC_RELEASE, "agent");
            asm volatile("s_waitcnt vmcnt(0)" ::: "memory");
            const unsigned og = xb_add(&bar[XB_TOP], 1u);
            const unsigned tg = og / nx;
            if (og + 1u == (tg + 1u) * nx) xb_add(&bar[XB_TOPGEN], 1u);
            else XB_SPIN(xb_ld(&bar[XB_TOPGEN]) == tg, bar);
            __builtin_amdgcn_fence(__ATOMIC_ACQUIRE, "agent");
            xb_add(&bar[XB_XGEN(b.x)], 1u);
            asm volatile("s_waitcnt vmcnt(0)" ::: "memory");
        } else {
            XB_SPIN(xb_ld(&bar[XB_XGEN(b.x)]) == gen, bar);
            __builtin_amdgcn_fence(__ATOMIC_ACQUIRE, "agent");
            asm volatile("s_waitcnt vmcnt(0)" ::: "memory");
        }
    }
    __syncthreads();
}


__device__ __forceinline__ float wave_sum(float v) {
#pragma unroll
    for (int o = 1; o < 64; o <<= 1) v += __shfl_xor(v, o);
    return v;
}
__device__ __forceinline__ float bflo(unsigned w) { return __uint_as_float(w << 16); }
__device__ __forceinline__ float bfhi(unsigned w) { return __uint_as_float(w & 0xffff0000u); }
__device__ __forceinline__ float bf2f(bf16 h) { return __uint_as_float((unsigned)h << 16); }
__device__ __forceinline__ float sigm(float x) { return 1.0f / (1.0f + __expf(-x)); }
__device__ __forceinline__ void row_geom(int m, int& t, int& T) { if (m < NTOK_P) { t = m & 4095; T = 4096; } else { t = (m - NTOK_P) & 2047; T = 2048; } }
__device__ __forceinline__ void seq_geom(int s, int& row0, int& T) { if (s < 4) { row0 = s * 4096; T = 4096; } else { row0 = NTOK_P + (s - 4) * 2048; T = 2048; } }

__device__ __forceinline__ void p0_transpose_item(const float* W, int N, bf16* WT, int ldk, int koff, int row_off, int mode, LAS float* scr, int item, int lane) {
    const int nblk = N / 32, kb = item / nblk, nb = item % nblk, k0 = 64 * kb, n0 = 32 * nb;
    int drow0 = row_off + n0;
    if (mode == 1) { const int up = n0 >= DFF ? 1 : 0, j0 = n0 - up * DFF; drow0 = (j0 / 128) * 256 + up * 128 + (j0 % 128); }
#pragma unroll 8
    for (int i = 0; i < 32; ++i) { const int kk = 2 * i + (lane >> 5); scr[kk * 33 + (lane & 31)] = W[(size_t)(k0 + kk) * N + n0 + (lane & 31)]; }
    LDS_WAIT(); asm volatile("" ::: "memory");
    const int c = lane & 7;
#pragma unroll
    for (int j = 0; j < 4; ++j) { const int n = (lane >> 3) + 8 * j; const LAS float* s = scr + (8 * c) * 33 + n;
        v4u o; o.x = pk2(s[0 * 33], s[1 * 33]); o.y = pk2(s[2 * 33], s[3 * 33]); o.z = pk2(s[4 * 33], s[5 * 33]); o.w = pk2(s[6 * 33], s[7 * 33]);
        *(GAS v4u*)(WT + (size_t)(drow0 + n) * ldk + koff + k0 + 8 * c) = o; }
    LDS_WAIT(); asm volatile("" ::: "memory");
}

struct Ptrs {
    const float* in[28]; float* out; unsigned char* ws;
};

__device__ __forceinline__ void ln_rows(const float* P, const float* g, const float* b, float* of32, bf16* ob16, int gw, int NGW, int lane) {
    for (int m = gw; m < NTOK; m += NGW) {
        const GAS f32x4* xr = (const GAS f32x4*)(P + (size_t)m * DM) + lane;
        f32x4 v[4]; float s = 0.f;
#pragma unroll
        for (int j = 0; j < 4; ++j) { v[j] = xr[64 * j]; s += (v[j].x + v[j].y) + (v[j].z + v[j].w); }
        const float mean = wave_sum(s) * (1.f / DM); float s2 = 0.f;
#pragma unroll
        for (int j = 0; j < 4; ++j) { v[j] = v[j] - mean; s2 += (v[j].x * v[j].x + v[j].y * v[j].y) + (v[j].z * v[j].z + v[j].w * v[j].w); }
        const float rstd = 1.f / sqrtf(wave_sum(s2) * (1.f / DM) + LN_EPS);
#pragma unroll
        for (int j = 0; j < 4; ++j) { const f32x4 gg = ((const GAS f32x4*)g)[lane + 64 * j], bb = ((const GAS f32x4*)b)[lane + 64 * j];
            v[j] = v[j] * rstd * gg + bb; }
        if (of32) { GAS f32x4* o = (GAS f32x4*)(of32 + (size_t)m * DM) + lane;
#pragma unroll
            for (int j = 0; j < 4; ++j) o[64 * j] = v[j]; }
        if (ob16) { GAS unsigned long long* o8 = (GAS unsigned long long*)(ob16 + (size_t)m * DM) + lane;
#pragma unroll
            for (int j = 0; j < 4; ++j) o8[64 * j] = (unsigned long long)pk2(v[j].x, v[j].y) | ((unsigned long long)pk2(v[j].z, v[j].w) << 32); }
    }
}

__device__ __forceinline__ void rope_phase(bf16* uR, const float2* TAB, int gtid, int NG) {
    for (int ch = gtid; ch < NTOK * 128; ch += NG) {
        const int m = ch >> 7, col = (ch & 127) * 8; int t, T; row_geom(m, t, T);
        const int j0 = (col & 127) >> 1;
        GAS v4u* p = (GAS v4u*)(uR + (size_t)m * RET_COLS + col);
        v4u w = *p;
        const float* tb = (const float*)(TAB + (size_t)t * 64 + j0);
        const float sc = col >= 512 ? 0.08838834764831845f : 1.0f;
        unsigned wv[4] = {w.x, w.y, w.z, w.w};
#pragma unroll
        for (int q = 0; q < 4; ++q) { const float cx = tb[2 * q], sx = tb[2 * q + 1]; const float x0 = bflo(wv[q]), x1 = bfhi(wv[q]);
            wv[q] = pk2((x0 * cx - x1 * sx) * sc, (x1 * cx + x0 * sx) * sc); }
        w.x = wv[0]; w.y = wv[1]; w.z = wv[2]; w.w = wv[3];
        *p = w;
    }
}


constexpr int TC = 32;
constexpr int SC_W = 0, SC_KD = 8192, SC_A = 16384, SC_B = 24576, SC_R = 32768, SC_AS = 40960, SC_V = 49152, SC_Y = 57344, SC_TH = 65536, SC_XA = 70144, SC_W2S = 74752, SC_A2S = 83968, SC_END = 93184;
constexpr int LSTR = 72;
typedef float f32x16 __attribute__((ext_vector_type(16)));
typedef unsigned v2u __attribute__((ext_vector_type(2)));

template <int CTRL> __device__ __forceinline__ float dpp_mov(float x) { return __uint_as_float((unsigned)__builtin_amdgcn_mov_dpp((int)__float_as_uint(x), CTRL, 0xf, 0xf, true)); }
__device__ __forceinline__ float allsum16(float x) {
    x += dpp_mov<0xB1>(x);
    x += dpp_mov<0x4E>(x);
    x += dpp_mov<0x124>(x);
    x += dpp_mov<0x128>(x);
    return x;
}
__device__ __forceinline__ float tanh_fast(float x) { return 1.0f - 2.0f / (1.0f + __expf(2.0f * x)); }

struct ScanRaw { v2u u[3][5]; };

__device__ __forceinline__ void scan_load_raw(ScanRaw& raw, const bf16* UA, int row0, int T, int d, int step, int h, int q4) {
    const int t = d ? (T - 1 - step) : step, m = row0 + t;
    const int mp = t > 0 ? m - 1 : m, mn = t < T - 1 ? m + 1 : m;
    const int rows[3] = {mp, m, mn};
    const int cols[5] = {h * 64 + q4, 512 + h * 64 + q4, 1024 + h * 64 + q4, 1536 + q4, 1600 + q4};
#pragma unroll
    for (int a = 0; a < 3; ++a)
#pragma unroll
        for (int b = 0; b < 5; ++b) raw.u[a][b] = *(const GAS v2u*)(UA + (size_t)rows[a] * RWKV_COLS + cols[b]);
}

template <int R>
__device__ __forceinline__ void scan_chain(LAS unsigned char* L, const bf16* UA, const float* const* in, bf16* Yd, float* BONUS, int d, int s, int h, int rbase, bool write_bonus) {
    const int tid = threadIdx.x, lane = tid & 63, wave = __builtin_amdgcn_readfirstlane(tid >> 6);
    int row0, T; seq_geom(s, row0, T);
    const float* mu_p = in[7]; const float* mu_n = in[8]; const float* w0 = in[9]; const float* w2 = in[10]; const float* a0 = in[11]; const float* a2 = in[12];
    const float* k_k = in[14]; const float* k_a = in[15]; const float* r_k = in[16];
    LAS float* Wl = (LAS float*)(L + SC_W); LAS float* KDl = (LAS float*)(L + SC_KD); LAS float* Al = (LAS float*)(L + SC_A); LAS float* Bl = (LAS float*)(L + SC_B);
    LAS float* Rl = (LAS float*)(L + SC_R); LAS float* ASl = (LAS float*)(L + SC_AS); LAS float* Vl = (LAS float*)(L + SC_V); LAS float* Yl = (LAS float*)(L + SC_Y);
    LAS bf16* THl = (LAS bf16*)(L + SC_TH); LAS bf16* XAl = (LAS bf16*)(L + SC_XA); LAS bf16* W2S = (LAS bf16*)(L + SC_W2S); LAS bf16* A2S = (LAS bf16*)(L + SC_A2S);
    __syncthreads();
    { const int j = tid >> 3, c8 = (tid & 7) * 8;
      const float* wsrc = w2 + ((size_t)d * 64 + j) * 512 + h * 64 + c8; const float* asrc = a2 + ((size_t)d * 64 + j) * 512 + h * 64 + c8;
#pragma unroll
      for (int i = 0; i < 8; ++i) { W2S[(c8 + i) * LSTR + j] = (bf16)f2bf(wsrc[i]); A2S[(c8 + i) * LSTR + j] = (bf16)f2bf(asrc[i]); } }
    const int tt_p = tid >> 4, q4 = (tid & 15) * 4;
    const int r32 = lane & 31, hi = lane >> 5, whichB = wave & 1, ntB = (wave >> 1) & 1;
    const float z0 = (whichB ? a0 : w0)[d * 512 + h * 64 + 32 * ntB + r32];
    const f32x4 kk4 = *(const GAS f32x4*)(k_k + h * 64 + q4), ka4 = *(const GAS f32x4*)(k_a + h * 64 + q4), rk4 = *(const GAS f32x4*)(r_k + h * 64 + q4);
    const int g = lane >> 4, qs = lane & 15, rowl = rbase + wave * 4 * R + g * R;
    float S[R][4];
#pragma unroll
    for (int rho = 0; rho < R; ++rho)
#pragma unroll
        for (int i = 0; i < 4; ++i) S[rho][i] = 0.f;
    ScanRaw raw; scan_load_raw(raw, UA, row0, T, d, tt_p, h, q4);
    for (int ch0 = 0; ch0 < T; ch0 += TC) {
        float rr[4], kv[4], vv[4];
        {
            const int colsA[5] = {h * 64 + q4, 512 + h * 64 + q4, 1024 + h * 64 + q4, 1536 + q4, 1600 + q4};
            const int step = ch0 + tt_p, t = d ? (T - 1 - step) : step;
            const float fp = t > 0 ? 1.f : 0.f, fn = t < T - 1 ? 1.f : 0.f;
            float sh[5][4];
#pragma unroll
            for (int b = 0; b < 5; ++b) { const f32x4 mp4 = *(const GAS f32x4*)(mu_p + colsA[b]), mn4 = *(const GAS f32x4*)(mu_n + colsA[b]);
                const float up[4] = {bflo(raw.u[0][b].x) * fp, bfhi(raw.u[0][b].x) * fp, bflo(raw.u[0][b].y) * fp, bfhi(raw.u[0][b].y) * fp};
                const float u0[4] = {bflo(raw.u[1][b].x), bfhi(raw.u[1][b].x), bflo(raw.u[1][b].y), bfhi(raw.u[1][b].y)};
                const float un[4] = {bflo(raw.u[2][b].x) * fn, bfhi(raw.u[2][b].x) * fn, bflo(raw.u[2][b].y) * fn, bfhi(raw.u[2][b].y) * fn};
#pragma unroll
                for (int i = 0; i < 4; ++i) sh[b][i] = u0[i] + mp4[i] * (up[i] - u0[i]) + mn4[i] * (un[i] - u0[i]); }
#pragma unroll
            for (int i = 0; i < 4; ++i) { rr[i] = sh[0][i]; kv[i] = sh[1][i]; vv[i] = sh[2][i]; }
            v2u th, xa; th.x = pk2(tanh_fast(sh[3][0]), tanh_fast(sh[3][1])); th.y = pk2(tanh_fast(sh[3][2]), tanh_fast(sh[3][3]));
            xa.x = pk2(sh[4][0], sh[4][1]); xa.y = pk2(sh[4][2], sh[4][3]);
            *(LAS v2u*)(THl + tt_p * LSTR + q4) = th; *(LAS v2u*)(XAl + tt_p * LSTR + q4) = xa;
        }
        if (ch0 + TC < T) scan_load_raw(raw, UA, row0, T, d, ch0 + TC + tt_p, h, q4);
        __syncthreads();
        if (wave < 4) {
            const LAS bf16* X = whichB ? XAl : THl; const LAS bf16* Wm = whichB ? A2S : W2S;
            f32x16 acc = {0.f, 0.f, 0.f, 0.f, 0.f, 0.f, 0.f, 0.f, 0.f, 0.f, 0.f, 0.f, 0.f, 0.f, 0.f, 0.f};
#pragma unroll
            for (int ks = 0; ks < 4; ++ks) {
                const bf16x8 af = *(const LAS bf16x8*)(X + r32 * LSTR + ks * 16 + hi * 8);
                const bf16x8 bfr = *(const LAS bf16x8*)(Wm + (32 * ntB + r32) * LSTR + ks * 16 + hi * 8);
                acc = __builtin_amdgcn_mfma_f32_32x32x16_bf16(af, bfr, acc, 0, 0, 0);
            }
            LAS float* dst = whichB ? ASl : Wl;
#pragma unroll
            for (int qq = 0; qq < 16; ++qq) { const int tt = (qq & 3) + 8 * (qq >> 2) + 4 * hi; const float sg = sigm(z0 + acc[qq]);
                dst[tt * 64 + 32 * ntB + r32] = whichB ? sg : __expf(-0.6065306597126334f * sg); }
        }
        __syncthreads();
        {
            const f32x4 as4 = *(const LAS f32x4*)(ASl + tt_p * 64 + q4);
            float kk0[4], ss = 0.f;
#pragma unroll
            for (int i = 0; i < 4; ++i) { kk0[i] = kv[i] * kk4[i]; ss += kk0[i] * kk0[i]; }
            ss = allsum16(ss);
            const float inv = 1.0f / fmaxf(sqrtf(ss), 1e-12f);
            f32x4 kd4, a4, b4, r4, v4; float bon = 0.f;
#pragma unroll
            for (int i = 0; i < 4; ++i) { const float kk = kk0[i] * inv; kd4[i] = kv[i] * (1.0f + (as4[i] - 1.0f) * ka4[i]); a4[i] = -kk; b4[i] = kk * as4[i]; r4[i] = rr[i]; v4[i] = vv[i];
                bon += rr[i] * kd4[i] * rk4[i]; }
            bon = allsum16(bon);
            *(LAS f32x4*)(KDl + tt_p * 64 + q4) = kd4; *(LAS f32x4*)(Al + tt_p * 64 + q4) = a4; *(LAS f32x4*)(Bl + tt_p * 64 + q4) = b4;
            *(LAS f32x4*)(Rl + tt_p * 64 + q4) = r4; *(LAS f32x4*)(Vl + tt_p * 64 + q4) = v4;
            if (write_bonus && (tid & 15) == 0) { const int step = ch0 + tt_p, t = d ? (T - 1 - step) : step; BONUS[(size_t)d * NTOK * 8 + (size_t)(row0 + t) * 8 + h] = bon; }
        }
        __syncthreads();
#pragma unroll 2
        for (int tt = 0; tt < TC; ++tt) {
            const f32x4 w = *(const LAS f32x4*)(Wl + tt * 64 + 4 * qs), kd = *(const LAS f32x4*)(KDl + tt * 64 + 4 * qs), a = *(const LAS f32x4*)(Al + tt * 64 + 4 * qs);
            const f32x4 b = *(const LAS f32x4*)(Bl + tt * 64 + 4 * qs), r = *(const LAS f32x4*)(Rl + tt * 64 + 4 * qs);
#pragma unroll
            for (int rho = 0; rho < R; ++rho) {
                const float v = Vl[tt * 64 + rowl + rho];
                float p = (S[rho][0] * a[0] + S[rho][1] * a[1]) + (S[rho][2] * a[2] + S[rho][3] * a[3]);
                float pre[4];
#pragma unroll
                for (int i = 0; i < 4; ++i) pre[i] = S[rho][i] * w[i] + v * kd[i];
                p = allsum16(p);
#pragma unroll
                for (int i = 0; i < 4; ++i) S[rho][i] = pre[i] + p * b[i];
                float y = (S[rho][0] * r[0] + S[rho][1] * r[1]) + (S[rho][2] * r[2] + S[rho][3] * r[3]);
                y = allsum16(y);
                if (qs == 0) Yl[tt * 64 + rowl + rho] = y;
            }
        }
        __syncthreads();
        {
            const int step = ch0 + tt_p, t = d ? (T - 1 - step) : step; const int cc = rbase + (tid & 15) * 2 * R;
            bf16* dstp = Yd + (size_t)(row0 + t) * 512 + h * 64 + cc;
            if (R == 2) { const f32x4 y4 = *(const LAS f32x4*)(Yl + tt_p * 64 + cc); v2u o; o.x = pk2(y4[0], y4[1]); o.y = pk2(y4[2], y4[3]); *(GAS v2u*)dstp = o; }
            else { const float y0 = Yl[tt_p * 64 + cc], y1 = Yl[tt_p * 64 + cc + 1]; *(GAS unsigned*)dstp = pk2(y0, y1); }
        }
    }
}

__device__ __forceinline__ void scan_phase(LAS unsigned char* L, const bf16* UA, const float* const* in, bf16* YF, bf16* YBW, float* BONUS, int bx, int G) {
    for (int wi = bx; wi < 256; wi += G) {
        if (wi < 128) { const int d = wi >> 6, rem = wi & 63, s = 4 + (rem >> 3), h = rem & 7; scan_chain<2>(L, UA, in, d ? YBW : YF, BONUS, d, s, h, 0, true); }
        else { const int pc = (wi - 128) >> 1, half = (wi - 128) & 1, d = pc >> 5, rem = pc & 31, s = rem >> 3, h = rem & 7; scan_chain<1>(L, UA, in, d ? YBW : YF, BONUS, d, s, h, 32 * half, half == 0); }
    }
}

constexpr int PO_SG = 0, PSTR = 136;
__device__ __forceinline__ void post_phase(LAS unsigned char* L, const bf16* UA, const float* const* in, const bf16* G2T, const bf16* YF, const bf16* YBW, const float* BONUS, bf16* YA, int vcu, int G) {
    const int tid = threadIdx.x, lane = tid & 63, wave = __builtin_amdgcn_readfirstlane(tid >> 6), r32 = lane & 31, hi = lane >> 5;
    const float* mu_p = in[7]; const float* mu_n = in[8]; const float* lnx_g = in[17]; const float* lnx_b = in[18];
    LAS bf16* SG = (LAS bf16*)(L + PO_SG);
    for (int unit = vcu; unit < NTOK / 64; unit += G) {
        const int m0 = unit * 64;
        __syncthreads();
        {
            const int i = tid >> 3, j16 = (tid & 7) * 16, m = m0 + i; int t, T; row_geom(m, t, T);
            const int mp = t > 0 ? m - 1 : m, mn = t < T - 1 ? m + 1 : m; const float fp = t > 0 ? 1.f : 0.f, fn = t < T - 1 ? 1.f : 0.f;
#pragma unroll
            for (int hf = 0; hf < 2; ++hf) { const int col = 1664 + j16 + 8 * hf;
                const v4u up = *(const GAS v4u*)(UA + (size_t)mp * RWKV_COLS + col), u0 = *(const GAS v4u*)(UA + (size_t)m * RWKV_COLS + col), un = *(const GAS v4u*)(UA + (size_t)mn * RWKV_COLS + col);
                const unsigned upw[4] = {up.x, up.y, up.z, up.w}, u0w[4] = {u0.x, u0.y, u0.z, u0.w}, unw[4] = {un.x, un.y, un.z, un.w}; unsigned ow[4];
#pragma unroll
                for (int e = 0; e < 4; ++e) { const float mpa = mu_p[col + 2 * e], mpb = mu_p[col + 2 * e + 1], mna = mu_n[col + 2 * e], mnb = mu_n[col + 2 * e + 1];
                    const float a0 = bflo(u0w[e]), b0 = bfhi(u0w[e]);
                    const float sa = a0 + mpa * (bflo(upw[e]) * fp - a0) + mna * (bflo(unw[e]) * fn - a0), sb = b0 + mpb * (bfhi(upw[e]) * fp - b0) + mnb * (bfhi(unw[e]) * fn - b0);
                    ow[e] = pk2(sigm(sa), sigm(sb)); }
                v4u o; o.x = ow[0]; o.y = ow[1]; o.z = ow[2]; o.w = ow[3];
                *(LAS v4u*)(SG + i * PSTR + j16 + 8 * hf) = o; }
        }
        __syncthreads();
        f32x16 acc[2][2];
#pragma unroll
        for (int mt = 0; mt < 2; ++mt)
#pragma unroll
            for (int nt = 0; nt < 2; ++nt)
#pragma unroll
                for (int e = 0; e < 16; ++e) acc[mt][nt][e] = 0.f;
#pragma unroll
        for (int ks = 0; ks < 8; ++ks) {
            bf16x8 af[2], bfr[2];
#pragma unroll
            for (int mt = 0; mt < 2; ++mt) af[mt] = *(const LAS bf16x8*)(SG + (32 * mt + r32) * PSTR + ks * 16 + hi * 8);
#pragma unroll
            for (int nt = 0; nt < 2; ++nt) bfr[nt] = *(const GAS bf16x8*)(G2T + (size_t)(64 * wave + 32 * nt + r32) * 128 + ks * 16 + hi * 8);
#pragma unroll
            for (int mt = 0; mt < 2; ++mt)
#pragma unroll
                for (int nt = 0; nt < 2; ++nt) acc[mt][nt] = __builtin_amdgcn_mfma_f32_32x32x16_bf16(af[mt], bfr[nt], acc[mt][nt], 0, 0, 0);
        }
        const int c0 = 64 * wave + r32;
        const float lg0 = lnx_g[c0], lg1 = lnx_g[c0 + 32], lb0 = lnx_b[c0], lb1 = lnx_b[c0 + 32];
        const float mpv0 = mu_p[1024 + c0], mpv1 = mu_p[1024 + c0 + 32], mnv0 = mu_n[1024 + c0], mnv1 = mu_n[1024 + c0 + 32];
#pragma unroll
        for (int mt = 0; mt < 2; ++mt)
#pragma unroll
            for (int e = 0; e < 16; ++e) {
                const int i = 32 * mt + (e & 3) + 8 * (e >> 2) + 4 * hi, m = m0 + i; int t, T; row_geom(m, t, T);
                const float y0 = bf2f(YF[(size_t)m * 512 + c0]) + bf2f(YBW[(size_t)m * 512 + c0]), y1 = bf2f(YF[(size_t)m * 512 + c0 + 32]) + bf2f(YBW[(size_t)m * 512 + c0 + 32]);
                float sm = y0 + y1;
                sm += __shfl_xor(sm, 1); sm += __shfl_xor(sm, 2); sm += __shfl_xor(sm, 4); sm += __shfl_xor(sm, 8); sm += __shfl_xor(sm, 16);
                const float mean = sm * (1.f / 64.f), d0 = y0 - mean, d1 = y1 - mean;
                float sq = d0 * d0 + d1 * d1;
                sq += __shfl_xor(sq, 1); sq += __shfl_xor(sq, 2); sq += __shfl_xor(sq, 4); sq += __shfl_xor(sq, 8); sq += __shfl_xor(sq, 16);
                const float rstd = 1.0f / sqrtf(sq * (1.f / 64.f) + 64e-5f);
                const float bonus = BONUS[(size_t)m * 8 + wave] + BONUS[(size_t)NTOK * 8 + (size_t)m * 8 + wave];
                const int mp = t > 0 ? m - 1 : m, mn = t < T - 1 ? m + 1 : m; const float fp = t > 0 ? 1.f : 0.f, fn = t < T - 1 ? 1.f : 0.f;
                const bf16* vp = UA + 1024 + c0;
                const float v00 = bf2f(vp[(size_t)m * RWKV_COLS]), v0p = bf2f(vp[(size_t)mp * RWKV_COLS]) * fp, v0n = bf2f(vp[(size_t)mn * RWKV_COLS]) * fn;
                const float v10 = bf2f(vp[(size_t)m * RWKV_COLS + 32]), v1p = bf2f(vp[(size_t)mp * RWKV_COLS + 32]) * fp, v1n = bf2f(vp[(size_t)mn * RWKV_COLS + 32]) * fn;
                const float vs0 = v00 + mpv0 * (v0p - v00) + mnv0 * (v0n - v00), vs1 = v10 + mpv1 * (v1p - v10) + mnv1 * (v1n - v10);
                const float o0 = (d0 * rstd * lg0 + lb0 + bonus * vs0) * acc[mt][0][e], o1 = (d1 * rstd * lg1 + lb1 + bonus * vs1) * acc[mt][1][e];
                YA[(size_t)m * 512 + c0] = (bf16)f2bf(o0); YA[(size_t)m * 512 + c0 + 32] = (bf16)f2bf(o1);
            }
    }
}

constexpr int RSTR = 136;
constexpr int RT_A = 0, RT_B = 34816, RT_C = 69632;
__device__ __forceinline__ float ret_lg(int h) { return log2f(1.0f - exp2f(-5.0f - (float)h)); }

__device__ __forceinline__ void ret_stage_T(LAS bf16* dst, const bf16* src, int tid, float f0, float f1) {
    const int jp = tid & 63, dq = (tid >> 6) * 16;
    const v4u a0 = *(const GAS v4u*)(src + (size_t)(2 * jp) * RET_COLS + dq), a1 = *(const GAS v4u*)(src + (size_t)(2 * jp) * RET_COLS + dq + 8);
    const v4u b0 = *(const GAS v4u*)(src + (size_t)(2 * jp + 1) * RET_COLS + dq), b1 = *(const GAS v4u*)(src + (size_t)(2 * jp + 1) * RET_COLS + dq + 8);
    const unsigned aw[8] = {a0.x, a0.y, a0.z, a0.w, a1.x, a1.y, a1.z, a1.w}, bw[8] = {b0.x, b0.y, b0.z, b0.w, b1.x, b1.y, b1.z, b1.w};
#pragma unroll
    for (int e = 0; e < 8; ++e) {
        *(LAS unsigned*)(dst + (dq + 2 * e) * RSTR + 2 * jp) = pk2(bflo(aw[e]) * f0, bflo(bw[e]) * f1);
        *(LAS unsigned*)(dst + (dq + 2 * e + 1) * RSTR + 2 * jp) = pk2(bfhi(aw[e]) * f0, bfhi(bw[e]) * f1);
    }
}
__device__ __forceinline__ void ret_stage_N(LAS bf16* dst, const bf16* src, int tid) {
    const int i = tid >> 2, sg = (tid & 3) * 32;
#pragma unroll
    for (int e = 0; e < 4; ++e) *(LAS v4u*)(dst + i * RSTR + sg + 8 * e) = *(const GAS v4u*)(src + (size_t)i * RET_COLS + sg + 8 * e);
}

__device__ __forceinline__ void ret_kv_phase(LAS unsigned char* L, const bf16* UR, bf16* KV, int vcu, int G) {
    const int tid = threadIdx.x, lane = tid & 63, wave = __builtin_amdgcn_readfirstlane(tid >> 6), r32 = lane & 31, hi = lane >> 5;
    LAS bf16* VT = (LAS bf16*)(L + RT_A); LAS bf16* KfT = (LAS bf16*)(L + RT_B); LAS bf16* KbT = (LAS bf16*)(L + RT_C);
    const int eb = wave & 3, dh = wave >> 2;
    for (int unit = vcu; unit < 1024; unit += G) {
        const int cidx = unit >> 2, h = unit & 3, m0 = cidx * 128; const float lg = ret_lg(h);
        __syncthreads();
        const int jp = tid & 63; const float j0 = (float)(2 * jp);
        ret_stage_T(VT, UR + (size_t)m0 * RET_COLS + 1024 + h * 128, tid, 1.0f, 1.0f);
        ret_stage_T(KfT, UR + (size_t)m0 * RET_COLS + 512 + h * 128, tid, exp2f(lg * (127.0f - j0)), exp2f(lg * (126.0f - j0)));
        ret_stage_T(KbT, UR + (size_t)m0 * RET_COLS + 512 + h * 128, tid, exp2f(lg * j0), exp2f(lg * (j0 + 1.0f)));
        __syncthreads();
        f32x16 acc[2][2];
#pragma unroll
        for (int a = 0; a < 2; ++a)
#pragma unroll
            for (int b = 0; b < 2; ++b)
#pragma unroll
                for (int e = 0; e < 16; ++e) acc[a][b][e] = 0.f;
#pragma unroll
        for (int ks = 0; ks < 8; ++ks) {
            const bf16x8 af = *(const LAS bf16x8*)(VT + (32 * eb + r32) * RSTR + ks * 16 + hi * 8);
#pragma unroll
            for (int nt = 0; nt < 2; ++nt) {
                const bf16x8 bf_ = *(const LAS bf16x8*)(KfT + (64 * dh + 32 * nt + r32) * RSTR + ks * 16 + hi * 8);
                const bf16x8 bb_ = *(const LAS bf16x8*)(KbT + (64 * dh + 32 * nt + r32) * RSTR + ks * 16 + hi * 8);
                acc[0][nt] = __builtin_amdgcn_mfma_f32_32x32x16_bf16(af, bf_, acc[0][nt], 0, 0, 0);
                acc[1][nt] = __builtin_amdgcn_mfma_f32_32x32x16_bf16(af, bb_, acc[1][nt], 0, 0, 0);
            }
        }
#pragma unroll
        for (int dir = 0; dir < 2; ++dir)
#pragma unroll
            for (int nt = 0; nt < 2; ++nt)
#pragma unroll
                for (int q = 0; q < 16; ++q) { const int e = 32 * eb + (q & 3) + 8 * (q >> 2) + 4 * hi, dd = 64 * dh + 32 * nt + r32;
                    KV[((size_t)(cidx * 4 + h) * 2 + dir) * 16384 + e * 128 + dd] = (bf16)f2bf(acc[dir][nt][q]); }
    }
}

__device__ __forceinline__ void ret_scan_phase(bf16* KV, int gtid, int NGT) {
    for (int it = gtid; it < 96 * 2048; it += NGT) {
        const int chain = it >> 11, e8 = (it & 2047) * 8; const int s = chain >> 3, h = (chain >> 1) & 3, dir = chain & 1;
        int row0, T; seq_geom(s, row0, T); const int c0 = row0 >> 7, NC = T >> 7;
        const float dec = exp2f(128.0f * ret_lg(h));
        float R[8];
#pragma unroll
        for (int i = 0; i < 8; ++i) R[i] = 0.f;
#pragma unroll 4
        for (int k = 0; k < NC; ++k) {
            const int n = dir ? (NC - 1 - k) : k;
            GAS v4u* p = (GAS v4u*)(KV + ((size_t)((c0 + n) * 4 + h) * 2 + dir) * 16384 + e8);
            const v4u w = *p; const unsigned ww[4] = {w.x, w.y, w.z, w.w};
            v4u o; o.x = pk2(R[0], R[1]); o.y = pk2(R[2], R[3]); o.z = pk2(R[4], R[5]); o.w = pk2(R[6], R[7]);
            *p = o;
#pragma unroll
            for (int i = 0; i < 4; ++i) { R[2 * i] = dec * R[2 * i] + bflo(ww[i]); R[2 * i + 1] = dec * R[2 * i + 1] + bfhi(ww[i]); }
        }
    }
}

__device__ __forceinline__ void ret_out_phase(LAS unsigned char* L, const bf16* UR, const bf16* KV, bf16* YB, int vcu, int G) {
    const int tid = threadIdx.x, lane = tid & 63, wave = __builtin_amdgcn_readfirstlane(tid >> 6), r32 = lane & 31, hi = lane >> 5;
    LAS bf16* Qs = (LAS bf16*)(L + RT_A); LAS bf16* Ks = (LAS bf16*)(L + RT_B); LAS bf16* VT = (LAS bf16*)(L + RT_C); LAS bf16* Ps = Qs;
    LAS float* Os = (LAS float*)(L + RT_A);
    const int ib = wave & 3, half = wave >> 2;
    for (int unit = vcu; unit < 1024; unit += G) {
        const int cidx = unit >> 2, h = unit & 3, m0 = cidx * 128; const float lg = ret_lg(h);
        __syncthreads();
        ret_stage_N(Qs, UR + (size_t)m0 * RET_COLS + h * 128, tid);
        ret_stage_N(Ks, UR + (size_t)m0 * RET_COLS + 512 + h * 128, tid);
        ret_stage_T(VT, UR + (size_t)m0 * RET_COLS + 1024 + h * 128, tid, 1.0f, 1.0f);
        __syncthreads();
        f32x16 af_[2], ab_[2], as_[2];
#pragma unroll
        for (int nt = 0; nt < 2; ++nt)
#pragma unroll
            for (int e = 0; e < 16; ++e) { af_[nt][e] = 0.f; ab_[nt][e] = 0.f; as_[nt][e] = 0.f; }
        const bf16* stf = KV + ((size_t)(cidx * 4 + h) * 2 + 0) * 16384; const bf16* stb = stf + 16384;
#pragma unroll
        for (int ks = 0; ks < 8; ++ks) {
            const bf16x8 qf = *(const LAS bf16x8*)(Qs + (32 * ib + r32) * RSTR + ks * 16 + hi * 8);
#pragma unroll
            for (int nt = 0; nt < 2; ++nt) {
                const int col = 64 * half + 32 * nt + r32;
                const bf16x8 sf = *(const GAS bf16x8*)(stf + (size_t)col * 128 + ks * 16 + hi * 8);
                const bf16x8 sb = *(const GAS bf16x8*)(stb + (size_t)col * 128 + ks * 16 + hi * 8);
                const bf16x8 kf = *(const LAS bf16x8*)(Ks + col * RSTR + ks * 16 + hi * 8);
                af_[nt] = __builtin_amdgcn_mfma_f32_32x32x16_bf16(qf, sf, af_[nt], 0, 0, 0);
                ab_[nt] = __builtin_amdgcn_mfma_f32_32x32x16_bf16(qf, sb, ab_[nt], 0, 0, 0);
                as_[nt] = __builtin_amdgcn_mfma_f32_32x32x16_bf16(qf, kf, as_[nt], 0, 0, 0);
            }
        }
        __syncthreads();
#pragma unroll
        for (int nt = 0; nt < 2; ++nt)
#pragma unroll
            for (int q = 0; q < 16; ++q) { const int i = 32 * ib + (q & 3) + 8 * (q >> 2) + 4 * hi, j = 64 * half + 32 * nt + r32;
                Ps[i * RSTR + j] = (bf16)f2bf(as_[nt][q] * exp2f(lg * fabsf((float)(i - j)))); }
        __syncthreads();
        f32x16 ao_[2];
#pragma unroll
        for (int nt = 0; nt < 2; ++nt)
#pragma unroll
            for (int e = 0; e < 16; ++e) ao_[nt][e] = 0.f;
#pragma unroll
        for (int ks = 0; ks < 8; ++ks) {
            const bf16x8 pf = *(const LAS bf16x8*)(Ps + (32 * ib + r32) * RSTR + ks * 16 + hi * 8);
#pragma unroll
            for (int nt = 0; nt < 2; ++nt) {
                const bf16x8 vf = *(const LAS bf16x8*)(VT + (64 * half + 32 * nt + r32) * RSTR + ks * 16 + hi * 8);
                ao_[nt] = __builtin_amdgcn_mfma_f32_32x32x16_bf16(pf, vf, ao_[nt], 0, 0, 0);
            }
        }
        __syncthreads();
#pragma unroll
        for (int nt = 0; nt < 2; ++nt)
#pragma unroll
            for (int q = 0; q < 16; ++q) { const int i = 32 * ib + (q & 3) + 8 * (q >> 2) + 4 * hi, e = 64 * half + 32 * nt + r32;
                Os[i * 132 + e] = ao_[nt][q] + exp2f(lg * (float)(i + 1)) * af_[nt][q] + exp2f(lg * (float)(128 - i)) * ab_[nt][q]; }
        __syncthreads();
        {
            const int i = tid >> 2, part = (tid & 3) * 32; float v[32], sm = 0.f;
#pragma unroll
            for (int e = 0; e < 8; ++e) { const f32x4 x = *(const LAS f32x4*)(Os + i * 132 + part + 4 * e); v[4 * e] = x[0]; v[4 * e + 1] = x[1]; v[4 * e + 2] = x[2]; v[4 * e + 3] = x[3]; sm += (x[0] + x[1]) + (x[2] + x[3]); }
            sm += __shfl_xor(sm, 1); sm += __shfl_xor(sm, 2);
            const float mean = sm * (1.f / 128.f); float sq = 0.f;
#pragma unroll
            for (int e = 0; e < 32; ++e) { v[e] -= mean; sq += v[e] * v[e]; }
            sq += __shfl_xor(sq, 1); sq += __shfl_xor(sq, 2);
            const float rstd = 1.0f / sqrtf(sq * (1.f / 128.f) + 1e-6f);
            const bf16* gp = UR + (size_t)(m0 + i) * RET_COLS + 1536 + h * 128 + part; bf16* op = YB + (size_t)(m0 + i) * 512 + h * 128 + part;
#pragma unroll
            for (int e = 0; e < 4; ++e) { const v4u gw_ = *(const GAS v4u*)(gp + 8 * e); const unsigned gwv[4] = {gw_.x, gw_.y, gw_.z, gw_.w}; unsigned ow[4];
#pragma unroll
                for (int p = 0; p < 4; ++p) { const float g0 = bflo(gwv[p]), g1 = bfhi(gwv[p]);
                    ow[p] = pk2(g0 * sigm(g0) * v[8 * e + 2 * p] * rstd, g1 * sigm(g1) * v[8 * e + 2 * p + 1] * rstd); }
                v4u o; o.x = ow[0]; o.y = ow[1]; o.z = ow[2]; o.w = ow[3]; *(GAS v4u*)(op + 8 * e) = o; }
        }
    }
}

struct Args { const float* in[28]; float* out; unsigned char* ws; int ph_lo, ph_hi, li, pad; };
constexpr int N_PHASES = 20;

__global__ void __launch_bounds__(NWAVES * 64, 2) mk(Args args) {
    extern __shared__ __attribute__((aligned(16))) unsigned char lds[];
    LAS unsigned char* L = (LAS unsigned char*)lds;
    volatile LAS unsigned* MISC = (volatile LAS unsigned*)(L + MISC_OFF);
    const int tid = threadIdx.x, lane = tid & 63, wave = __builtin_amdgcn_readfirstlane(tid >> 6);
    const int G = gridDim.x; const int bx = blockIdx.x; const int vcu = (G % 8 == 0) ? (bx % 8) * (G / 8) + bx / 8 : bx;
    unsigned char* ws = args.ws; unsigned char* dout = (unsigned char*)args.out;
    gu32* ctl = (gu32*)(ws + WS_CTL);
    for (int u = tid; u < (LDS_BYTES - LDSCTL_OFF) / 4; u += NWAVES * 64) ((LAS unsigned*)(L + LDSCTL_OFF))[u] = 0u;
    __syncthreads();
    const int lo = args.ph_lo, hi = args.ph_hi;
    const bool use_bar = (hi - lo) > 1;
    XcdBarrier bar; bar.bar = (unsigned*)(ctl + CW_BAR) + args.li * XCD_BAR_WORDS; bar.x = 0; bar.st = nullptr;
    if (use_bar) bar = xcd_barrier_post((unsigned*)(ctl + CW_BAR) + args.li * XCD_BAR_WORDS, MISC + 8);
#define IN(k) (lo <= (k) && (k) < hi)
#define SEAM(k) do { if (IN(k) && IN((k) + 1)) xcd_barrier(bar); } while (0)
    const int gw = vcu * NWAVES + wave, NGW = G * NWAVES;
    const int gtid = vcu * (NWAVES * 64) + tid, NGT = G * NWAVES * 64;
    const float* xp = args.in[0]; const float* xs = args.in[1];
    bf16* W_UP1 = (bf16*)(ws + WS_W_UP1); bf16* W_DN1 = (bf16*)(ws + WS_W_DN1); bf16* W_IN = (bf16*)(ws + WS_W_IN);
    bf16* W_BR = (bf16*)(ws + WS_W_BR); bf16* W_OUT = (bf16*)(ws + WS_W_OUT); bf16* W_UP2 = (bf16*)(ws + WS_W_UP2); bf16* W_DN2 = (bf16*)(ws + WS_W_DN2);
    float2* TAB = (float2*)(ws + WS_TAB);
    bf16* XB = (bf16*)(dout + DO_XB); bf16* X1B = (bf16*)(ws + WS_X1B); bf16* X2B = (bf16*)(ws + WS_X2B);
    bf16* H1 = (bf16*)(ws + WS_H1); bf16* H2 = (bf16*)(ws + WS_H2);
    bf16* UR = (bf16*)(ws + WS_BIG); bf16* UA = (bf16*)(ws + WS_BIG); bf16* HB = (bf16*)(ws + WS_BIG);
    bf16* YA = (bf16*)(dout + DO_YA); bf16* YB = (bf16*)(dout + DO_YB);
    float* PF = args.out;

    if (IN(0)) {
        LAS float* scr = (LAS float*)(L + RING_OFF + wave * 16384);
        constexpr int I_UP = 16 * 176, I_DN = 44 * 32, I_IN = 16 * 184, I_BR = 8 * 32, I_OUT = 16 * 32;
        constexpr int I_G2 = 2 * 16; constexpr int NITEMS = 2 * I_UP + I_DN + I_IN + 2 * I_BR + 2 * I_OUT + I_G2;
        for (int it = gw; it < NITEMS; it += NGW) {
            int r = it;
            if (r < I_UP) { p0_transpose_item(args.in[2], 2 * DFF, W_UP1, DM, 0, 0, 1, scr, r, lane); continue; } r -= I_UP;
            if (r < I_UP) { p0_transpose_item(args.in[24], 2 * DFF, W_UP2, DM, 0, 0, 1, scr, r, lane); continue; } r -= I_UP;
            if (r < I_DN) { p0_transpose_item(args.in[3], DM, W_DN1, DFF, 0, 0, 0, scr, r, lane); continue; } r -= I_DN;
            if (r < I_IN) { p0_transpose_item(args.in[6], IN_COLS, W_IN, DM, 0, 0, 0, scr, r, lane); continue; } r -= I_IN;
            if (r < I_BR) { p0_transpose_item(args.in[19], DM, W_BR, 512, 0, 0, 0, scr, r, lane); continue; } r -= I_BR;
            if (r < I_BR) { p0_transpose_item(args.in[20], DM, W_BR, 512, 0, 1024, 0, scr, r, lane); continue; } r -= I_BR;
            if (r < I_OUT) { p0_transpose_item(args.in[21], DM, W_OUT, 2048, 0, 0, 0, scr, r, lane); continue; } r -= I_OUT;
            if (r < I_OUT) { p0_transpose_item(args.in[21], DM, W_OUT, 2048, 1024, 0, 0, scr, r, lane); continue; } r -= I_OUT;
            p0_transpose_item(args.in[13], 512, (bf16*)(ws + WS_G2T), 128, 0, 0, 0, scr, r, lane);
        }
        for (int m = gw; m < NTOK; m += NGW) {
            const float* xrow = (m < NTOK_P) ? xp + (size_t)m * DM : xs + (size_t)(m - NTOK_P) * DM;
            const GAS f32x4* xr = (const GAS f32x4*)xrow + lane; GAS unsigned long long* o8 = (GAS unsigned long long*)(XB + (size_t)m * DM) + lane;
#pragma unroll
            for (int j = 0; j < 4; ++j) { const f32x4 v = xr[64 * j]; o8[64 * j] = (unsigned long long)pk2(v.x, v.y) | ((unsigned long long)pk2(v.z, v.w) << 32); }
        }
        for (int e = gtid; e < 4096 * 64; e += NGT) {
            const int t = e >> 6, j = e & 63;
            const float ang = (float)(1.0 / pow(10000.0, (double)j / 63.0));
            const float th = (float)t * ang;
            TAB[e] = make_float2((float)cos((double)th), (float)sin((double)th));
        }
    }
    SEAM(0);
    if (IN(1)) { pg8::Gemm g{XB, W_UP1, NTOK, 2 * DFF, DM}; pg8::StaticOrder S; S.init(NTOK, 2 * DFF, G, bx);
        pg8::EpiSwiglu E{H1, DFF}; pg8::gemm_phase<pg8::EpiSwiglu, pg8::StaticOrder, true, true>(L + RING_OFF, g, S, E); }
    SEAM(1);
    if (IN(2)) { pg8::Gemm g{H1, W_DN1, NTOK, DM, DFF}; pg8::StaticOrder S; S.init(NTOK, DM, G, bx);
        pg8::EpiResidual<0> E{xp, xs, NTOK_P, nullptr, PF, DM, ALPHA, 0.5f}; pg8::gemm_phase<pg8::EpiResidual<0>, pg8::StaticOrder, true, true>(L + RING_OFF, g, S, E); }
    SEAM(2);
    if (IN(3)) ln_rows(PF, args.in[4], args.in[5], nullptr, X1B, gw, NGW, lane);
    SEAM(3);
    if (IN(4)) { pg8::Gemm g{X1B, W_IN + (size_t)RWKV_COLS * DM, NTOK, RET_COLS, DM}; pg8::StaticOrder S; S.init(NTOK, RET_COLS, G, bx);
        pg8::EpiStoreBf16 E{UR, RET_COLS}; pg8::gemm_phase<pg8::EpiStoreBf16, pg8::StaticOrder, true, true>(L + RING_OFF, g, S, E); }
    SEAM(4);
    if (IN(5)) rope_phase(UR, TAB, gtid, NGT);
    SEAM(5);
    if (IN(6)) ret_kv_phase(L + RING_OFF, UR, (bf16*)(dout + DO_KV), vcu, G);
    SEAM(6);
    if (IN(7)) ret_scan_phase((bf16*)(dout + DO_KV), gtid, NGT);
    SEAM(7);
    if (IN(8)) ret_out_phase(L + RING_OFF, UR, (const bf16*)(dout + DO_KV), YB, vcu, G);
    SEAM(8);
    if (IN(9)) { pg8::Gemm g{X1B, W_IN, NTOK, RWKV_COLS, DM}; pg8::StaticOrder S; S.init(NTOK, RWKV_COLS, G, bx);
        pg8::EpiStoreBf16 E{UA, RWKV_COLS}; pg8::gemm_phase<pg8::EpiStoreBf16, pg8::StaticOrder, true, true>(L + RING_OFF, g, S, E); }
    SEAM(9);
    if (IN(10)) scan_phase(L + RING_OFF, UA, args.in, (bf16*)(dout + DO_YF), (bf16*)(dout + DO_YBW), (float*)(ws + WS_BONUS), bx, G);
    SEAM(10);
    if (IN(11)) post_phase(L + RING_OFF, UA, args.in, (const bf16*)(ws + WS_G2T), (const bf16*)(dout + DO_YF), (const bf16*)(dout + DO_YBW), (const float*)(ws + WS_BONUS), YA, vcu, G);
    SEAM(11);
    if (IN(12)) {
        { pg8::Gemm g{YA, W_BR, NTOK, DM, 512}; pg8::StaticOrder S; S.init(NTOK, DM, G, bx);
          pg8::EpiStoreBf16 E{HB, 2048}; pg8::gemm_phase<pg8::EpiStoreBf16, pg8::StaticOrder, true, true>(L + RING_OFF, g, S, E); }
        { pg8::Gemm g{YB, W_BR + (size_t)1024 * 512, NTOK, DM, 512}; pg8::StaticOrder S; S.init(NTOK, DM, G, bx);
          pg8::EpiStoreBf16 E{HB + 1024, 2048}; pg8::gemm_phase<pg8::EpiStoreBf16, pg8::StaticOrder, true, true>(L + RING_OFF, g, S, E); }
    }
    SEAM(12);
    if (IN(13)) { pg8::Gemm g{X1B, W_IN + (size_t)(RWKV_COLS + RET_COLS) * DM, NTOK, GATE_COLS, DM}; pg8::StaticOrder S; S.init(NTOK, GATE_COLS, G, bx);
        pg8::EpiGateMul E{HB, 2048}; pg8::gemm_phase<pg8::EpiGateMul, pg8::StaticOrder, true, true>(L + RING_OFF, g, S, E); }
    SEAM(13);
    if (IN(14)) { pg8::Gemm g{HB, W_OUT, NTOK, DM, 2048}; pg8::StaticOrder S; S.init(NTOK, DM, G, bx);
        pg8::EpiResidual<1> E{nullptr, nullptr, 0, X1B, PF, DM, ALPHA, 1.0f}; pg8::gemm_phase<pg8::EpiResidual<1>, pg8::StaticOrder, true, true>(L + RING_OFF, g, S, E); }
    SEAM(14);
    if (IN(15)) ln_rows(PF, args.in[22], args.in[23], PF, X2B, gw, NGW, lane);
    SEAM(15);
    if (IN(16)) { pg8::Gemm g{X2B, W_UP2, NTOK, 2 * DFF, DM}; pg8::StaticOrder S; S.init(NTOK, 2 * DFF, G, bx);
        pg8::EpiSwiglu E{H2, DFF}; pg8::gemm_phase<pg8::EpiSwiglu, pg8::StaticOrder, true, true>(L + RING_OFF, g, S, E); }
    SEAM(16);
    if (IN(17)) { LAS float* scr = (LAS float*)(L + RING_OFF + wave * 16384);
        for (int it = gw; it < 44 * 32; it += NGW) p0_transpose_item(args.in[25], DM, W_DN2, DFF, 0, 0, 0, scr, it, lane); }
    SEAM(17);
    if (IN(18)) { pg8::Gemm g{H2, W_DN2, NTOK, DM, DFF}; pg8::StaticOrder S; S.init(NTOK, DM, G, bx);
        pg8::EpiResidual<0> E{PF, PF, NTOK, nullptr, PF, DM, ALPHA, 0.5f}; pg8::gemm_phase<pg8::EpiResidual<0>, pg8::StaticOrder, true, true>(L + RING_OFF, g, S, E); }
    SEAM(18);
    if (IN(19)) ln_rows(PF, args.in[26], args.in[27], PF, nullptr, gw, NGW, lane);
#undef IN
#undef SEAM
}

__device__ __forceinline__ float shifted(const bf16* UA, int m, int t, int T, int col, float mp, float mn) {
    const float u0 = bf2f(UA[(size_t)m * RWKV_COLS + col]);
    const float up = t > 0 ? bf2f(UA[(size_t)(m - 1) * RWKV_COLS + col]) : 0.f;
    const float un = t < T - 1 ? bf2f(UA[(size_t)(m + 1) * RWKV_COLS + col]) : 0.f;
    return u0 + mp * (up - u0) + mn * (un - u0);
}

__global__ void __launch_bounds__(64) naive_scan(const bf16* UA, const float* mu_p, const float* mu_n, const float* w0, const float* w2, const float* a0, const float* a2,
                                                 const float* k_k, const float* k_a, const float* r_k, bf16* YF, bf16* YBW, float* BONUS) {
    const int c = blockIdx.x, d = c / 96, rem = c % 96, s = rem / 8, h = rem % 8, lane = threadIdx.x;
    int row0, T; seq_geom(s, row0, T);
    __shared__ float sr[64], sw[64], sk[64], sa[64], sb[64], sxw[64], sxa[64];
    float S[64];
#pragma unroll
    for (int k = 0; k < 64; ++k) S[k] = 0.f;
    const int ch = h * 64 + lane, cr = ch, ck = 512 + ch, cv = 1024 + ch, cxw = 1536 + lane, cxa = 1600 + lane;
    const float mpr = mu_p[cr], mnr = mu_n[cr], mpk = mu_p[ck], mnk = mu_n[ck], mpv = mu_p[cv], mnv = mu_n[cv];
    const float mpw = mu_p[cxw], mnw = mu_n[cxw], mpa = mu_p[cxa], mna = mu_n[cxa];
    const float w0c = w0[d * 512 + ch], a0c = a0[d * 512 + ch], kkc = k_k[ch], kac = k_a[ch], rkc = r_k[ch];
    const float* w2d = w2 + (size_t)d * 64 * 512 + ch; const float* a2d = a2 + (size_t)d * 64 * 512 + ch;
    bf16* Y = d == 0 ? YF : YBW;
    for (int step = 0; step < T; ++step) {
        const int t = d ? (T - 1 - step) : step, m = row0 + t;
        const float r = shifted(UA, m, t, T, cr, mpr, mnr), k = shifted(UA, m, t, T, ck, mpk, mnk), v = shifted(UA, m, t, T, cv, mpv, mnv);
        const float xw = shifted(UA, m, t, T, cxw, mpw, mnw), xa = shifted(UA, m, t, T, cxa, mpa, mna);
        sxw[lane] = tanhf(xw); sxa[lane] = xa;
        __syncthreads();
        float zw = w0c, za = a0c;
#pragma unroll 8
        for (int j = 0; j < 64; ++j) { zw += sxw[j] * w2d[(size_t)j * 512]; za += sxa[j] * a2d[(size_t)j * 512]; }
        const float decay = __expf(-0.6065306597126334f * sigm(zw)), asig = sigm(za);
        const float kk0 = k * kkc; const float nrm = sqrtf(wave_sum(kk0 * kk0)); const float kk = kk0 / fmaxf(nrm, 1e-12f);
        const float kd = k * (1.0f + (asig - 1.0f) * kac);
        const float bon = wave_sum(r * kd * rkc);
        if (lane == 0) BONUS[(size_t)d * NTOK * 8 + (size_t)m * 8 + h] = bon;
        sr[lane] = r; sw[lane] = decay; sk[lane] = kd; sa[lane] = -kk; sb[lane] = kk * asig;
        __syncthreads();
        float sav = 0.f;
#pragma unroll
        for (int q = 0; q < 64; ++q) sav += S[q] * sa[q];
        float y = 0.f;
#pragma unroll
        for (int q = 0; q < 64; ++q) { S[q] = S[q] * sw[q] + sav * sb[q] + v * sk[q]; y += S[q] * sr[q]; }
        Y[(size_t)m * 512 + ch] = (bf16)f2bf(y);
        __syncthreads();
    }
}

__global__ void __launch_bounds__(64) naive_post(const bf16* UA, const float* mu_p, const float* mu_n, const float* g2, const float* lnx_g, const float* lnx_b,
                                                 const bf16* YF, const bf16* YBW, const float* BONUS, bf16* YA) {
    const int m = blockIdx.x >> 3, h = blockIdx.x & 7, lane = threadIdx.x, ch = h * 64 + lane;
    int t, T; row_geom(m, t, T);
    __shared__ float sg[128];
#pragma unroll
    for (int q = 0; q < 2; ++q) { const int col = 1664 + lane + 64 * q; sg[lane + 64 * q] = sigm(shifted(UA, m, t, T, col, mu_p[col], mu_n[col])); }
    __syncthreads();
    float g = 0.f;
#pragma unroll 8
    for (int j = 0; j < 128; ++j) g += sg[j] * g2[(size_t)j * 512 + ch];
    const float y = bf2f(YF[(size_t)m * 512 + ch]) + bf2f(YBW[(size_t)m * 512 + ch]);
    const float mean = wave_sum(y) * (1.f / 64.f); const float dv = y - mean; const float var = wave_sum(dv * dv) * (1.f / 64.f);
    const float yn = dv * (1.0f / sqrtf(var + 64e-5f)) * lnx_g[ch] + lnx_b[ch];
    const float bonus = BONUS[(size_t)m * 8 + h] + BONUS[(size_t)NTOK * 8 + (size_t)m * 8 + h];
    const float v = shifted(UA, m, t, T, 1024 + ch, mu_p[1024 + ch], mu_n[1024 + ch]);
    YA[(size_t)m * 512 + ch] = (bf16)f2bf((yn + bonus * v) * g);
}

__global__ void __launch_bounds__(256) naive_ret(const bf16* UR, bf16* YBo) {
    const int pidx = blockIdx.x >> 2, h = blockIdx.x & 3, tid = threadIdx.x, m0 = 2 * pidx;
    int t0, T; row_geom(m0, t0, T); const int row0 = m0 - t0;
    __shared__ float sc[2][4096]; __shared__ float qs[2][128]; __shared__ float red[4];
    { const int qi = tid >> 7, dd = tid & 127; qs[qi][dd] = bf2f(UR[(size_t)(m0 + qi) * RET_COLS + h * 128 + dd]); }
    __syncthreads();
    const float lg = log2f(1.0f - exp2f(-5.0f - (float)h));
    for (int j = tid; j < T; j += 256) {
        const v4u* kr = (const v4u*)(UR + (size_t)(row0 + j) * RET_COLS + 512 + h * 128);
        float d0 = 0.f, d1 = 0.f;
#pragma unroll 4
        for (int c8 = 0; c8 < 16; ++c8) { const v4u w = kr[c8]; const unsigned wv[4] = {w.x, w.y, w.z, w.w};
#pragma unroll
            for (int q = 0; q < 4; ++q) { const float k0 = bflo(wv[q]), k1 = bfhi(wv[q]); const int dd = c8 * 8 + q * 2;
                d0 += k0 * qs[0][dd] + k1 * qs[0][dd + 1]; d1 += k0 * qs[1][dd] + k1 * qs[1][dd + 1]; } }
        sc[0][j] = d0 * exp2f(lg * fabsf((float)(t0 - j))); sc[1][j] = d1 * exp2f(lg * fabsf((float)(t0 + 1 - j)));
    }
    __syncthreads();
    const int qi = tid >> 7, e = tid & 127;
    float o = 0.f;
    const bf16* vcol = UR + (size_t)row0 * RET_COLS + 1024 + h * 128 + e;
    for (int j = 0; j < T; ++j) o += sc[qi][j] * bf2f(vcol[(size_t)j * RET_COLS]);
    float sm = wave_sum(o); if ((tid & 63) == 0) red[tid >> 6] = sm;
    __syncthreads();
    const float mean = (red[2 * qi] + red[2 * qi + 1]) * (1.f / 128.f);
    __syncthreads();
    const float dv = o - mean; float sq = wave_sum(dv * dv); if ((tid & 63) == 0) red[tid >> 6] = sq;
    __syncthreads();
    const float var = (red[2 * qi] + red[2 * qi + 1]) * (1.f / 128.f);
    const float gt = bf2f(UR[(size_t)(m0 + qi) * RET_COLS + 1536 + h * 128 + e]);
    const float sil = gt / (1.0f + __expf(-gt));
    YBo[(size_t)(m0 + qi) * 512 + h * 128 + e] = (bf16)f2bf(sil * dv * (1.0f / sqrtf(var + 1e-6f)));
}

#ifndef MK_FUSE
#define MK_FUSE 1
#endif
extern "C" void kernel_launch(void* const* d_in, const int* in_sizes, int n_in, void* d_out, int out_size, void* d_ws, size_t ws_size, hipStream_t stream) {
    static int grid = 0;
    if (grid == 0) {
        if (n_in != 28 || out_size != NTOK * DM || ws_size < WS_END) { fprintf(stderr, "kernel_launch: unexpected problem (n_in %d, out %d, ws %zu); nothing launched\n", n_in, out_size, ws_size); grid = -1; return; }
        int dev = 0, cus = 0, per_cu = 0;
        if (hipGetDevice(&dev) != hipSuccess || hipDeviceGetAttribute(&cus, hipDeviceAttributeMultiprocessorCount, dev) != hipSuccess) { grid = -1; return; }
        if (hipFuncSetAttribute((const void*)mk, hipFuncAttributeMaxDynamicSharedMemorySize, LDS_BYTES) != hipSuccess) { fprintf(stderr, "kernel_launch: hipFuncSetAttribute failed\n"); grid = -1; return; }
        if (hipOccupancyMaxActiveBlocksPerMultiprocessor(&per_cu, (const void*)mk, NWAVES * 64, LDS_BYTES) != hipSuccess || per_cu < 1) { fprintf(stderr, "kernel_launch: occupancy query says %d blocks per CU\n", per_cu); }
        (void)hipGetLastError();
        grid = cus;
    }
    if (grid < 0) return;
    (void)hipMemsetAsync((char*)d_ws + WS_CTL, 0, CTL_ZERO_BYTES, stream);
    Args a{};
    for (int i = 0; i < 28; ++i) a.in[i] = (const float*)d_in[i];
    a.out = (float*)d_out; a.ws = (unsigned char*)d_ws;
    unsigned char* ws = (unsigned char*)d_ws; unsigned char* dout = (unsigned char*)d_out;
    int li = 0;
    auto run = [&](int lo, int hi) {
#if MK_FUSE
        a.ph_lo = lo; a.ph_hi = hi; a.li = li++; hipLaunchKernelGGL(mk, dim3(grid), dim3(NWAVES * 64), LDS_BYTES, stream, a);
#else
        for (int k = lo; k < hi; ++k) { a.ph_lo = k; a.ph_hi = k + 1; a.li = 0; hipLaunchKernelGGL(mk, dim3(grid), dim3(NWAVES * 64), LDS_BYTES, stream, a); }
#endif
    };
    const bf16* UR = (const bf16*)(ws + WS_BIG); const bf16* UA = (const bf16*)(ws + WS_BIG);
    bf16* YF = (bf16*)(dout + DO_YF); bf16* YBW = (bf16*)(dout + DO_YBW); bf16* YB = (bf16*)(dout + DO_YB); bf16* YA = (bf16*)(dout + DO_YA);
    float* BONUS = (float*)(ws + WS_BONUS);
    run(0, N_PHASES);
    (void)UR; (void)YB;
    (void)UA; (void)YF; (void)YBW; (void)YA; (void)BONUS;
}
```

```cpp
#include <hip/hip_runtime.h>
#include <cstdio>
#include <cstdint>
#include <cmath>
namespace pg8 {
#define PG8_LAS __attribute__((address_space(3)))
typedef unsigned short bf16_t;
typedef short bf16x8 __attribute__((ext_vector_type(8)));
typedef float f32x4 __attribute__((ext_vector_type(4)));
typedef unsigned u32x4 __attribute__((ext_vector_type(4)));
constexpr int BM = 256, BK = 64, HALF = 128, HTB = HALF * BK * 2  , STAGE_BYTES = 8 * HTB, NXCD = 8, WGM = 8;

__host__ __device__ __forceinline__ int lds_byte(int r, int c) { const int st = (r >> 4) * 2 + (c >> 5), rr = r & 15, cc = c & 31, ob = rr * 64 + cc * 2; return st * 1024 + (ob ^ (((ob >> 9) & 1) << 5)); }
__host__ __device__ __forceinline__ void stage_rc(int b, int& R, int& C) { const int st = b / 1024, sb = b % 1024, swz = sb ^ (((sb >> 9) & 1) << 5); R = (st >> 1) * 16 + swz / 64; C = (st & 1) * 32 + (swz % 64) / 2; }
__host__ __device__ __forceinline__ int perm32(int rho) { const int n = rho >> 4, i = rho & 15; return 8 * (i >> 2) + 4 * n + (i & 3); }

struct Unit { int pm, pn; };
struct Gemm { const bf16_t* A; const bf16_t* Bt; int M, N, K; };

struct StaticOrder {
    int nM, nN, nwg, G, c;
    __host__ __device__ void init(int M, int N, int G_, int c_) { nM = M / BM; nN = N / BM; nwg = nM * nN; G = G_; c = c_; }
    __host__ __device__ bool next(int i, Unit& u) const {
        const long L = (long)i * G + c; if (L >= nwg) return false;
        int wgid = (int)L; { const int q = nwg / NXCD, r = nwg % NXCD, xcd = wgid % NXCD, off = wgid / NXCD; wgid = (xcd < r ? xcd * (q + 1) : r * (q + 1) + (xcd - r) * q) + off; }
        const int nig = WGM * nN, gid = wgid / nig, fm = gid * WGM, gsz = (nM - fm) < WGM ? (nM - fm) : WGM;
        u.pm = fm + ((wgid % nig) % gsz); u.pn = (wgid % nig) / gsz; return true;
    }
    __device__ __forceinline__ void a_ready(const Unit&) const {}
    __device__ __forceinline__ void done(const Unit&) const {}
};

__device__ __forceinline__ unsigned cvt_pk_bf16(float lo, float hi) { unsigned r; asm volatile("v_cvt_pk_bf16_f32 %0, %1, %2" : "=v"(r) : "v"(lo), "v"(hi)); return r; }
typedef float f32x2 __attribute__((ext_vector_type(2)));
__device__ __forceinline__ float sigmoidf_fast(float x) { return __builtin_amdgcn_rcpf(1.0f + __builtin_amdgcn_exp2f(-1.4426950408889634f * x)); }
__device__ __forceinline__ float siluf_fast(float x) { return x * sigmoidf_fast(x); }
__device__ __forceinline__ float bf16_lo(unsigned w) { return __uint_as_float(w << 16); }
__device__ __forceinline__ float bf16_hi(unsigned w) { return __uint_as_float(w & 0xffff0000u); }

template <bool HALO> struct EpiStoreBf16 {
    static constexpr bool PERM = true, AFTER_DRAIN = false;
    bf16_t* O; int ldc; bf16_t* halo;
    __device__ __forceinline__ void operator()(const f32x4 (&acc)[2][2][4][2], const Unit& u, int wr, int wc, int fr, int fq) const {
        const int row0 = u.pm * BM + wr * 64 + fr, col0 = u.pn * BM + wc * 32 + 8 * fq;
#pragma unroll
        for (int ai = 0; ai < 2; ++ai)
#pragma unroll
            for (int m = 0; m < 4; ++m) { const int row = row0 + ai * HALF + m * 16; bf16_t* rowp = O + (size_t)row * ldc + col0;
#pragma unroll
                for (int bj = 0; bj < 2; ++bj) { const f32x4 v0 = acc[ai][bj][m][0], v1 = acc[ai][bj][m][1];
                    u32x4 w; w.x = cvt_pk_bf16(v0[0], v0[1]); w.y = cvt_pk_bf16(v0[2], v0[3]); w.z = cvt_pk_bf16(v1[0], v1[1]); w.w = cvt_pk_bf16(v1[2], v1[3]);
                    *(u32x4*)(rowp + bj * HALF) = w;
                    if (HALO && (m == 0 || m == 3)) { const int r6 = row & 63; if (r6 == 0 || r6 == 63) *(u32x4*)(halo + (size_t)((row >> 6) * 2 + (r6 ? 1 : 0)) * ldc + col0 + bj * HALF) = w; } } }
    }
};
struct EpiSwiglu {
    static constexpr bool PERM = true, AFTER_DRAIN = false;
    bf16_t* H; int ldh;
    __device__ __forceinline__ void operator()(const f32x4 (&acc)[2][2][4][2], const Unit& u, int wr, int wc, int fr, int fq) const {
        const int row0 = u.pm * BM + wr * 64 + fr, col0 = u.pn * HALF + wc * 32 + 8 * fq;
#pragma unroll
        for (int ai = 0; ai < 2; ++ai)
#pragma unroll
            for (int m = 0; m < 4; ++m) { bf16_t* rowp = H + (size_t)(row0 + ai * HALF + m * 16) * ldh + col0;
                const f32x4 g0 = acc[ai][0][m][0], g1 = acc[ai][0][m][1], u0 = acc[ai][1][m][0], u1 = acc[ai][1][m][1];
                float h[8];
#pragma unroll
                for (int i = 0; i < 4; ++i) { h[i] = siluf_fast(g0[i]) * u0[i]; h[4 + i] = siluf_fast(g1[i]) * u1[i]; }
                u32x4 w; w.x = cvt_pk_bf16(h[0], h[1]); w.y = cvt_pk_bf16(h[2], h[3]); w.z = cvt_pk_bf16(h[4], h[5]); w.w = cvt_pk_bf16(h[6], h[7]);
                *(u32x4*)rowp = w; }
    }
};
struct EpiGateMul {
    static constexpr bool PERM = true, AFTER_DRAIN = false;
    bf16_t* HB; int ldc;
    __device__ __forceinline__ void operator()(const f32x4 (&acc)[2][2][4][2], const Unit& u, int wr, int wc, int fr, int fq) const {
        const int row0 = u.pm * BM + wr * 64 + fr, col0 = u.pn * BM + wc * 32 + 8 * fq;
#pragma unroll
        for (int ai = 0; ai < 2; ++ai)
#pragma unroll
            for (int m = 0; m < 4; ++m) { bf16_t* rowp = HB + (size_t)(row0 + ai * HALF + m * 16) * ldc + col0;
#pragma unroll
                for (int bj = 0; bj < 2; ++bj) { const f32x4 v0 = acc[ai][bj][m][0], v1 = acc[ai][bj][m][1];
                    const u32x4 hb = *(const u32x4*)(rowp + bj * HALF);
                    u32x4 w;
                    w.x = cvt_pk_bf16(sigmoidf_fast(v0[0]) * bf16_lo(hb.x), sigmoidf_fast(v0[1]) * bf16_hi(hb.x));
                    w.y = cvt_pk_bf16(sigmoidf_fast(v0[2]) * bf16_lo(hb.y), sigmoidf_fast(v0[3]) * bf16_hi(hb.y));
                    w.z = cvt_pk_bf16(sigmoidf_fast(v1[0]) * bf16_lo(hb.z), sigmoidf_fast(v1[1]) * bf16_hi(hb.z));
                    w.w = cvt_pk_bf16(sigmoidf_fast(v1[2]) * bf16_lo(hb.w), sigmoidf_fast(v1[3]) * bf16_hi(hb.w));
                    *(u32x4*)(rowp + bj * HALF) = w; } }
    }
};
template <int RES> struct EpiResidual {
    static constexpr bool PERM = false, AFTER_DRAIN = false;
    const float* r0; const float* r1; int split; const bf16_t* rb; float* out; int ldc; float alpha, scale;
    __device__ __forceinline__ void operator()(const f32x4 (&acc)[2][2][4][2], const Unit& u, int wr, int wc, int fr, int fq) const {
        const int row0 = u.pm * BM + wr * 64 + fr, col0 = u.pn * BM + wc * 32 + 4 * fq;
#pragma unroll
        for (int ai = 0; ai < 2; ++ai)
#pragma unroll
            for (int m = 0; m < 4; ++m) { const int row = row0 + ai * HALF + m * 16;
                const float* resf = (row < split) ? r0 + (size_t)row * ldc : r1 + (size_t)(row - split) * ldc;
#pragma unroll
                for (int bj = 0; bj < 2; ++bj)
#pragma unroll
                    for (int n = 0; n < 2; ++n) { const int c = col0 + bj * HALF + n * 16; f32x4 rv;
                        if (RES == 0) rv = *(const f32x4*)(resf + c);
                        else { const unsigned long long w = *(const unsigned long long*)(rb + (size_t)row * ldc + c); const unsigned lo = (unsigned)w, hi = (unsigned)(w >> 32);
                            rv = (f32x4){bf16_lo(lo), bf16_hi(lo), bf16_lo(hi), bf16_hi(hi)}; }
                        *(f32x4*)(out + (size_t)row * ldc + c) = rv * alpha + acc[ai][bj][m][n] * scale; } }
    }
};

template <class Epi, class Sched, bool ALIGN_EPI = false, bool SP2 = false>
__device__ __forceinline__ void gemm_phase(PG8_LAS unsigned char* lds, const Gemm g, const Sched& S, const Epi& E) {
    const int tid = threadIdx.x, wid = __builtin_amdgcn_readfirstlane(tid >> 6), lane = tid & 63, wr = wid >> 2, wc = wid & 3, fr = lane & 15, fq = lane >> 4;
    const int K = g.K, nt = K / BK;
    unsigned voffA[2], voffB[2];
#pragma unroll
    for (int i = 0; i < 2; ++i) { int R, C; stage_rc(tid * 16 + i * 8192, R, C); const int Rb = Epi::PERM ? ((R & ~31) + perm32(R & 31)) : R;
        voffA[i] = (unsigned)(R * K + C) * 2u; voffB[i] = (unsigned)(Rb * K + C) * 2u; }
    const size_t kstep = (size_t)(BK * 2);
    const size_t hstep = (size_t)HALF * K * 2;
    const size_t tstep = 2 * hstep;
    const unsigned ldsw = (unsigned)wid * 1024u;
    const int aoff = lds_byte(wr * 64 + fr, fq * 8), boff = lds_byte(wc * 32 + fr, fq * 8);
#define PG8_SA(b, h) (((b) * 2 + (h)) * HTB)
#define PG8_SB(b, h) ((4 + (b) * 2 + (h)) * HTB)
#define PG8_STAGE(bufoff, gbase, voff) do { _Pragma("unroll") for (int _i = 0; _i < 2; ++_i) \
        __builtin_amdgcn_global_load_lds((const unsigned*)((const char*)(gbase) + (voff)[_i]), (PG8_LAS unsigned*)(lds + (bufoff) + ldsw + _i * 8192), 16, 0, 0); } while (0)
#define PG8_LDA(dst, b, h) do { _Pragma("unroll") for (int m = 0; m < 4; ++m) _Pragma("unroll") for (int k = 0; k < 2; ++k) dst[m][k] = *(const PG8_LAS bf16x8*)(lds + PG8_SA(b, h) + aoff + m * 2048 + k * 1024); } while (0)
#define PG8_LDB(dst, b, h) do { _Pragma("unroll") for (int n = 0; n < 2; ++n) _Pragma("unroll") for (int k = 0; k < 2; ++k) dst[n][k] = *(const PG8_LAS bf16x8*)(lds + PG8_SB(b, h) + boff + n * 2048 + k * 1024); } while (0)
#define PG8_MMA(ai, bj, At, Bt) do { __builtin_amdgcn_s_setprio(1); _Pragma("unroll") for (int m = 0; m < 4; ++m) _Pragma("unroll") for (int n = 0; n < 2; ++n) _Pragma("unroll") for (int k = 0; k < 2; ++k) \
        acc[ai][bj][m][n] = __builtin_amdgcn_mfma_f32_16x16x32_bf16(Bt[n][k], At[m][k], acc[ai][bj][m][n], 0, 0, 0); __builtin_amdgcn_s_setprio(0); } while (0)
#define PG8_WAIT_V(n) asm volatile("s_waitcnt vmcnt(" #n ")" ::: "memory")
#define PG8_WAIT_L(n) asm volatile("s_waitcnt lgkmcnt(" #n ")" ::: "memory")
#define PG8_BAR __builtin_amdgcn_s_barrier()
#define PG8_SCHED __builtin_amdgcn_sched_barrier(0)
    Unit cur, nxt; int ui = 0;
    if (!S.next(0, cur)) return;
    f32x4 acc[2][2][4][2];
#pragma unroll
    for (int a = 0; a < 2; ++a)
#pragma unroll
        for (int b = 0; b < 2; ++b)
#pragma unroll
            for (int m = 0; m < 4; ++m)
#pragma unroll
                for (int n = 0; n < 2; ++n) acc[a][b][m][n] = (f32x4){0.f, 0.f, 0.f, 0.f};
    bf16x8 At[4][2], B0[2][2], B1[2][2];
    const char* cA = (const char*)g.A + (size_t)cur.pm * tstep; const char* cB = (const char*)g.Bt + (size_t)cur.pn * tstep;
    S.a_ready(cur);
    if constexpr (SP2) {
        PG8_STAGE(PG8_SB(0, 0), cB, voffB); PG8_STAGE(PG8_SB(0, 1), cB + hstep, voffB); PG8_STAGE(PG8_SA(0, 0), cA, voffA); PG8_STAGE(PG8_SA(0, 1), cA + hstep, voffA);
        if (wr == 1) PG8_BAR;
        PG8_WAIT_V(2); PG8_BAR;
        PG8_STAGE(PG8_SB(1, 0), cB + kstep, voffB); PG8_STAGE(PG8_SA(1, 0), cA + kstep, voffA); PG8_STAGE(PG8_SB(1, 1), cB + hstep + kstep, voffB);
        PG8_WAIT_V(6); PG8_BAR;
    } else {
        PG8_STAGE(PG8_SB(0, 0), cB, voffB); PG8_STAGE(PG8_SA(0, 0), cA, voffA); PG8_STAGE(PG8_SB(0, 1), cB + hstep, voffB); PG8_STAGE(PG8_SA(0, 1), cA + hstep, voffA);
        if (wr == 1) PG8_BAR;
        PG8_WAIT_V(4); PG8_BAR;
        PG8_STAGE(PG8_SB(1, 0), cB + kstep, voffB); PG8_STAGE(PG8_SA(1, 0), cA + kstep, voffA); PG8_STAGE(PG8_SB(1, 1), cB + hstep + kstep, voffB);
        PG8_WAIT_V(6); PG8_BAR;
    }
    for (;;) {
        const bool has_next = S.next(ui + 1, nxt);
        const char* nA = has_next ? (const char*)g.A + (size_t)nxt.pm * tstep : cA; const char* nB = has_next ? (const char*)g.Bt + (size_t)nxt.pn * tstep : cB;
        for (int t = 0; t < nt; t += 2) {
            const bool last = (t == nt - 2);
            const char* a1 = cA + (size_t)(t + 1) * kstep;
            const char* a2 = last ? nA : cA + (size_t)(t + 2) * kstep; const char* b2 = last ? nB : cB + (size_t)(t + 2) * kstep;
            const char* a3 = a2 + kstep; const char* b3 = b2 + kstep;
            if (last && has_next) S.a_ready(nxt);
            if constexpr (SP2) {
            PG8_LDB(B0, 0, 0); PG8_LDB(B1, 0, 1); PG8_SCHED; PG8_LDA(At, 0, 0); PG8_STAGE(PG8_SA(1, 1), a1 + hstep, voffA);
            PG8_WAIT_V(8); PG8_WAIT_L(0); PG8_BAR; PG8_MMA(0, 0, At, B0); PG8_MMA(0, 1, At, B1); PG8_BAR; PG8_SCHED;
            PG8_LDA(At, 0, 1); PG8_STAGE(PG8_SB(0, 0), b2, voffB); PG8_STAGE(PG8_SB(0, 1), b2 + hstep, voffB); PG8_STAGE(PG8_SA(0, 0), a2, voffA);
            PG8_WAIT_V(8); PG8_WAIT_L(0); PG8_BAR; PG8_MMA(1, 0, At, B0); PG8_MMA(1, 1, At, B1); PG8_BAR; PG8_SCHED;
            PG8_LDB(B0, 1, 0); PG8_LDB(B1, 1, 1); PG8_SCHED; PG8_LDA(At, 1, 0); PG8_STAGE(PG8_SA(0, 1), a2 + hstep, voffA);
            PG8_WAIT_V(8); PG8_WAIT_L(0); PG8_BAR; PG8_MMA(0, 0, At, B0); PG8_MMA(0, 1, At, B1); PG8_BAR; PG8_SCHED;
            PG8_LDA(At, 1, 1); PG8_STAGE(PG8_SB(1, 0), b3, voffB); PG8_STAGE(PG8_SB(1, 1), b3 + hstep, voffB); PG8_STAGE(PG8_SA(1, 0), a3, voffA);
            PG8_WAIT_V(8); PG8_WAIT_L(0); PG8_BAR; PG8_MMA(1, 0, At, B0); PG8_MMA(1, 1, At, B1); PG8_BAR; PG8_SCHED;
            } else {
            PG8_LDB(B0, 0, 0); PG8_SCHED; PG8_LDA(At, 0, 0); PG8_STAGE(PG8_SA(1, 1), a1 + hstep, voffA);
            PG8_WAIT_L(8); PG8_BAR; PG8_WAIT_L(0); PG8_MMA(0, 0, At, B0); PG8_BAR; PG8_SCHED;
            PG8_LDB(B1, 0, 1); PG8_STAGE(PG8_SB(0, 0), b2, voffB);
            PG8_BAR; PG8_WAIT_L(0); PG8_MMA(0, 1, At, B1); PG8_BAR;
            PG8_LDA(At, 0, 1); PG8_STAGE(PG8_SA(0, 0), a2, voffA);
            PG8_BAR; PG8_WAIT_L(0); PG8_MMA(1, 0, At, B0); PG8_BAR; PG8_SCHED;
            PG8_STAGE(PG8_SB(0, 1), b2 + hstep, voffB);
            PG8_WAIT_V(6); PG8_BAR; PG8_MMA(1, 1, At, B1); PG8_BAR;
            PG8_LDB(B0, 1, 0); PG8_SCHED; PG8_LDA(At, 1, 0); PG8_STAGE(PG8_SA(0, 1), a2 + hstep, voffA);
            PG8_WAIT_L(8); PG8_BAR; PG8_WAIT_L(0); PG8_MMA(0, 0, At, B0); PG8_BAR; PG8_SCHED;
            PG8_LDB(B1, 1, 1); PG8_STAGE(PG8_SB(1, 0), b3, voffB);
            PG8_BAR; PG8_WAIT_L(0); PG8_MMA(0, 1, At, B1); PG8_BAR;
            PG8_LDA(At, 1, 1); PG8_STAGE(PG8_SA(1, 0), a3, voffA);
            PG8_BAR; PG8_WAIT_L(0); PG8_MMA(1, 0, At, B0); PG8_BAR; PG8_SCHED;
            PG8_STAGE(PG8_SB(1, 1), b3 + hstep, voffB);
            PG8_WAIT_V(6); PG8_BAR; PG8_MMA(1, 1, At, B1); PG8_BAR;
            }
        }
        if constexpr (ALIGN_EPI) { if (wr == 0) PG8_BAR; }
        if constexpr (!Epi::AFTER_DRAIN) { E(acc, cur, wr, wc, fr, fq); S.done(cur); }
        if (!has_next) break;
#pragma unroll
        for (int a = 0; a < 2; ++a)
#pragma unroll
            for (int b = 0; b < 2; ++b)
#pragma unroll
                for (int m = 0; m < 4; ++m)
#pragma unroll
                    for (int n = 0; n < 2; ++n) acc[a][b][m][n] = (f32x4){0.f, 0.f, 0.f, 0.f};
        cur = nxt; cA = nA; cB = nB; ++ui;
        if constexpr (ALIGN_EPI) { if (wr == 1) PG8_BAR; }
    }
    PG8_WAIT_V(0);
    if constexpr (!ALIGN_EPI) { if (wr == 0) PG8_BAR; }
    PG8_BAR;
    if constexpr (Epi::AFTER_DRAIN) { E.fused(acc, cur, wr, wc, fr, fq, lds, wid, lane); S.done(cur); }
#undef PG8_SA
#undef PG8_SB
#undef PG8_STAGE
#undef PG8_LDA
#undef PG8_LDB
#undef PG8_MMA
#undef PG8_WAIT_V
#undef PG8_WAIT_L
#undef PG8_BAR
#undef PG8_SCHED
}
}

constexpr int NWAVES = 8;
constexpr int NTOK = 32768, NTOK_P = 16384, DM = 1024, DFF = 2816;
constexpr int RWKV_COLS = 1792, RET_COLS = 2048, GATE_COLS = 2048, IN_COLS = 5888;
constexpr float ALPHA = 1.189207115002721f, LN_EPS = 1e-5f;
constexpr size_t MiB = 1u << 20;
constexpr size_t WS_CTL = 0, CTL_ZERO_BYTES = 1 * MiB;
constexpr size_t WS_W_UP2 = 1 * MiB;
constexpr size_t WS_W_DN2 = 1 * MiB;
constexpr size_t WS_W_UP1 = 12 * MiB;
constexpr size_t WS_W_DN1 = 23 * MiB;
constexpr size_t WS_W_IN = 29 * MiB;
constexpr size_t WS_G2T = 40 * MiB + 512 * 1024;
constexpr size_t WS_W_BR = 41 * MiB;
constexpr size_t WS_W_OUT = 43 * MiB;
constexpr size_t WS_TAB = 47 * MiB;
constexpr size_t WS_X1B = 49 * MiB;
constexpr size_t WS_BIG = 113 * MiB;
constexpr size_t WS_HALO = 226 * MiB;
constexpr size_t WS_BONUS = 242 * MiB;
constexpr size_t WS_H1 = 49 * MiB;
constexpr size_t WS_X2B = 12 * MiB;
constexpr size_t WS_H2 = 76 * MiB;
constexpr size_t WS_END = 256 * MiB;
constexpr size_t DO_XB = 0;
constexpr size_t DO_KV = 0;
constexpr size_t DO_YF = 0, DO_YBW = 32 * MiB;
constexpr size_t DO_YB = 64 * MiB;
constexpr size_t DO_YA = 96 * MiB;
constexpr int CW_BAR = 4096;
constexpr int RING_OFF = 0, RING_BYTES = 131072;
constexpr int LDSCTL_OFF = 162816, MISC_OFF = LDSCTL_OFF + 320;
constexpr int LDS_BYTES = 163840;
#define GAS __attribute__((address_space(1)))
#define LAS __attribute__((address_space(3)))
typedef unsigned short bf16;
typedef unsigned v4u __attribute__((ext_vector_type(4)));
typedef float f32x4 __attribute__((ext_vector_type(4)));
typedef short bf16x8 __attribute__((ext_vector_type(8)));
typedef GAS unsigned gu32;
typedef GAS unsigned long long gu64;
#define RLX_AGENT __ATOMIC_RELAXED, __HIP_MEMORY_SCOPE_AGENT
#define LDS_WAIT() asm volatile("s_waitcnt lgkmcnt(0)" ::: "memory")
#define VM_WAIT() asm volatile("s_waitcnt vmcnt(0)" ::: "memory")
__device__ __forceinline__ unsigned long long rt() { return __builtin_amdgcn_s_memrealtime(); }
__device__ __forceinline__ unsigned f2bf(float f) { unsigned u = __builtin_bit_cast(unsigned, f); return (u + 0x7fffu + ((u >> 16) & 1u)) >> 16; }
__device__ __forceinline__ unsigned pk2(float lo, float hi) { return f2bf(lo) | (f2bf(hi) << 16); }

#define XB_TMO      128
#define XB_XCNT(j)  (256  + 64 * (j))
#define XB_XSUB(j)  (1280 + 64 * (j))
#define XB_XGEN(j)  (2304 + 64 * (j))
#define XB_TOP      3328
#define XB_TOPGEN   3392
#define XCD_BAR_WORDS 3456
#define XB_SPIN_CAP (1u << 18)

__device__ __forceinline__ unsigned xb_ld(unsigned* p)              { return __hip_atomic_load(p, __ATOMIC_RELAXED, __HIP_MEMORY_SCOPE_AGENT); }
__device__ __forceinline__ unsigned xb_add(unsigned* p, unsigned v) { return __hip_atomic_fetch_add(p, v, __ATOMIC_RELAXED, __HIP_MEMORY_SCOPE_AGENT); }
__device__ __forceinline__ unsigned xb_xcc_id() { return (unsigned)__builtin_amdgcn_s_getreg((3 << 11) | 20) & 0xFu; }
#define XB_SPIN(cond, bar) do { unsigned _sp = 0; while (cond) { __builtin_amdgcn_s_sleep(1); \
    if ((++_sp & 255u) == 0u) { if (xb_ld(&(bar)[XB_TMO])) break; if (_sp > XB_SPIN_CAP) { atomicAdd(&(bar)[XB_TMO], 1u); break; } } } } while (0)

struct XcdBarrier {
    unsigned* bar; unsigned x;
    volatile LAS unsigned* st;
};

__device__ __forceinline__ XcdBarrier xcd_barrier_post(unsigned* bar, volatile LAS unsigned* st) {
    XcdBarrier b; b.bar = bar; b.x = xb_xcc_id(); b.st = st;
    if (threadIdx.x == 0) (void)xb_add(&bar[XB_XCNT(b.x)], 1u);
    return b;
}
__device__ __forceinline__ void xcd_barrier_complete(unsigned* bar, unsigned x, unsigned& nloc, unsigned& nx) {
    const unsigned G = gridDim.x * gridDim.y * gridDim.z;
    unsigned sum, cnt, mine, sp = 0u;
    for (;;) {
        sum = 0u; cnt = 0u; mine = 0u;
#pragma unroll
        for (unsigned j = 0; j < 16; ++j) { const unsigned c = xb_ld(&bar[XB_XCNT(j)]); sum += c; cnt += (c > 0u) ? 1u : 0u; mine = (j == x) ? c : mine; }
        if (sum == G) break;
        __builtin_amdgcn_s_sleep(1);
        if ((++sp & 255u) == 0u) { if (xb_ld(&bar[XB_TMO])) break; if (sp > XB_SPIN_CAP) { atomicAdd(&bar[XB_TMO], 1u); break; } }
    }
    nloc = mine > 0u ? mine : 1u; nx = cnt > 0u ? cnt : 1u;
}

__device__ __forceinline__ void xcd_barrier(const XcdBarrier& b) {
    asm volatile("s_waitcnt vmcnt(0)" ::: "memory");
    __syncthreads();
    if (threadIdx.x == 0) {
        unsigned* bar = b.bar;
        __builtin_amdgcn_s_waitcnt(0);
        unsigned nloc = b.st[0], nx = b.st[1];
        if (nloc == 0u) { xcd_barrier_complete(bar, b.x, nloc, nx); b.st[0] = nloc; b.st[1] = nx; }
        const unsigned old = xb_add(&bar[XB_XSUB(b.x)], 1u);
        const unsigned gen = old / nloc;
        if (old + 1u == (gen + 1u) * nloc) {
            __builtin_amdgcn_fence(__ATOMIC_RELEASE, "agent");
            asm volatile("s_waitcnt vmcnt(0)" ::: "memory");
            const unsigned og = xb_add(&bar[XB_TOP], 1u);
            const unsigned tg = og / nx;
            if (og + 1u == (tg + 1u) * nx) xb_add(&bar[XB_TOPGEN], 1u);
            else XB_SPIN(xb_ld(&bar[XB_TOPGEN]) == tg, bar);
            __builtin_amdgcn_fence(__ATOMIC_ACQUIRE, "agent");
            xb_add(&bar[XB_XGEN(b.x)], 1u);
            asm volatile("s_waitcnt vmcnt(0)" ::: "memory");
        } else {
            XB_SPIN(xb_ld(&bar[XB_XGEN(b.x)]) == gen, bar);
            __builtin_amdgcn_fence(__ATOMIC_ACQUIRE, "agent");
            asm volatile("s_waitcnt vmcnt(0)" ::: "memory");
        }
    }
    __syncthreads();
}


__device__ __forceinline__ float wave_sum(float v) {
#pragma unroll
    for (int o = 1; o < 64; o <<= 1) v += __shfl_xor(v, o);
    return v;
}
__device__ __forceinline__ float bflo(unsigned w) { return __uint_as_float(w << 16); }
__device__ __forceinline__ float bfhi(unsigned w) { return __uint_as_float(w & 0xffff0000u); }
__device__ __forceinline__ float bf2f(bf16 h) { return __uint_as_float((unsigned)h << 16); }
__device__ __forceinline__ float sigm(float x) { return 1.0f / (1.0f + __expf(-x)); }
__device__ __forceinline__ void row_geom(int m, int& t, int& T) { if (m < NTOK_P) { t = m & 4095; T = 4096; } else { t = (m - NTOK_P) & 2047; T = 2048; } }
__device__ __forceinline__ void seq_geom(int s, int& row0, int& T) { if (s < 4) { row0 = s * 4096; T = 4096; } else { row0 = NTOK_P + (s - 4) * 2048; T = 2048; } }

__device__ __forceinline__ void p0_transpose_item(const float* W, int N, bf16* WT, int ldk, int koff, int row_off, int mode, LAS float* scr, int item, int lane) {
    const int nblk = N / 32, kb = item / nblk, nb = item % nblk, k0 = 64 * kb, n0 = 32 * nb;
    int drow0 = row_off + n0;
    if (mode == 1) { const int up = n0 >= DFF ? 1 : 0, j0 = n0 - up * DFF; drow0 = (j0 / 128) * 256 + up * 128 + (j0 % 128); }
#pragma unroll 8
    for (int i = 0; i < 32; ++i) { const int kk = 2 * i + (lane >> 5); scr[kk * 33 + (lane & 31)] = W[(size_t)(k0 + kk) * N + n0 + (lane & 31)]; }
    LDS_WAIT(); asm volatile("" ::: "memory");
    const int c = lane & 7;
#pragma unroll
    for (int j = 0; j < 4; ++j) { const int n = (lane >> 3) + 8 * j; const LAS float* s = scr + (8 * c) * 33 + n;
        v4u o; o.x = pk2(s[0 * 33], s[1 * 33]); o.y = pk2(s[2 * 33], s[3 * 33]); o.z = pk2(s[4 * 33], s[5 * 33]); o.w = pk2(s[6 * 33], s[7 * 33]);
        *(GAS v4u*)(WT + (size_t)(drow0 + n) * ldk + koff + k0 + 8 * c) = o; }
    LDS_WAIT(); asm volatile("" ::: "memory");
}

struct Ptrs {
    const float* in[28]; float* out; unsigned char* ws;
};

__device__ __forceinline__ void ln_rows(const float* P, const float* g, const float* b, float* of32, bf16* ob16, int gw, int NGW, int lane) {
    for (int m = gw; m < NTOK; m += NGW) {
        const GAS f32x4* xr = (const GAS f32x4*)(P + (size_t)m * DM) + lane;
        f32x4 v[4]; float s = 0.f;
#pragma unroll
        for (int j = 0; j < 4; ++j) { v[j] = xr[64 * j]; s += (v[j].x + v[j].y) + (v[j].z + v[j].w); }
        const float mean = wave_sum(s) * (1.f / DM); float s2 = 0.f;
#pragma unroll
        for (int j = 0; j < 4; ++j) { v[j] = v[j] - mean; s2 += (v[j].x * v[j].x + v[j].y * v[j].y) + (v[j].z * v[j].z + v[j].w * v[j].w); }
        const float rstd = 1.f / sqrtf(wave_sum(s2) * (1.f / DM) + LN_EPS);
#pragma unroll
        for (int j = 0; j < 4; ++j) { const f32x4 gg = ((const GAS f32x4*)g)[lane + 64 * j], bb = ((const GAS f32x4*)b)[lane + 64 * j];
            v[j] = v[j] * rstd * gg + bb; }
        if (of32) { GAS f32x4* o = (GAS f32x4*)(of32 + (size_t)m * DM) + lane;
#pragma unroll
            for (int j = 0; j < 4; ++j) o[64 * j] = v[j]; }
        if (ob16) { GAS unsigned long long* o8 = (GAS unsigned long long*)(ob16 + (size_t)m * DM) + lane;
#pragma unroll
            for (int j = 0; j < 4; ++j) o8[64 * j] = (unsigned long long)pk2(v[j].x, v[j].y) | ((unsigned long long)pk2(v[j].z, v[j].w) << 32); }
    }
}

__device__ __forceinline__ void rope_phase(bf16* uR, const float2* TAB, int gtid, int NG) {
    for (int ch = gtid; ch < NTOK * 128; ch += NG) {
        const int m = ch >> 7, col = (ch & 127) * 8; int t, T; row_geom(m, t, T);
        const int j0 = (col & 127) >> 1;
        GAS v4u* p = (GAS v4u*)(uR + (size_t)m * RET_COLS + col);
        v4u w = *p;
        const float* tb = (const float*)(TAB + (size_t)t * 64 + j0);
        const float sc = col >= 512 ? 0.08838834764831845f : 1.0f;
        unsigned wv[4] = {w.x, w.y, w.z, w.w};
#pragma unroll
        for (int q = 0; q < 4; ++q) { const float cx = tb[2 * q], sx = tb[2 * q + 1]; const float x0 = bflo(wv[q]), x1 = bfhi(wv[q]);
            wv[q] = pk2((x0 * cx - x1 * sx) * sc, (x1 * cx + x0 * sx) * sc); }
        w.x = wv[0]; w.y = wv[1]; w.z = wv[2]; w.w = wv[3];
        *p = w;
    }
}


typedef float f32x16 __attribute__((ext_vector_type(16)));
typedef float f32x2v __attribute__((ext_vector_type(2)));
typedef unsigned v2u __attribute__((ext_vector_type(2)));
__device__ __forceinline__ float rcp_fast(float x) { return __builtin_amdgcn_rcpf(x); }
__device__ __forceinline__ float sigm_fast(float x) { return rcp_fast(1.0f + __expf(-x)); }
__device__ __forceinline__ float tanh_fast(float x) { return 1.0f - 2.0f * rcp_fast(1.0f + __expf(2.0f * x)); }
__device__ __forceinline__ void unpack8(float (&f)[8], const v4u w) { f[0] = bflo(w.x); f[1] = bfhi(w.x); f[2] = bflo(w.y); f[3] = bfhi(w.y); f[4] = bflo(w.z); f[5] = bfhi(w.z); f[6] = bflo(w.w); f[7] = bfhi(w.w); }
__device__ __forceinline__ void shift_phase(bf16* UA, const bf16* HALO, const float* mu_p, const float* mu_n, int gtid, int NGT) {
    for (int it = gtid; it < 512 * 224; it += NGT) {
        const int tile = it / 224, col = (it % 224) * 8, row0 = tile * 64; int t0, T; row_geom(row0, t0, T);
        const int mode = (col >= 1536 && col < 1600) ? 1 : (col >= 1664 ? 2 : 0);
        float mp[8], mn[8];
        { const f32x4 a = *(const GAS f32x4*)(mu_p + col), b = *(const GAS f32x4*)(mu_p + col + 4), c = *(const GAS f32x4*)(mu_n + col), d = *(const GAS f32x4*)(mu_n + col + 4);
#pragma unroll
          for (int i = 0; i < 4; ++i) { mp[i] = a[i]; mp[4 + i] = b[i]; mn[i] = c[i]; mn[4 + i] = d[i]; } }
        float prev[8], cur[8];
        { v4u z = {0u, 0u, 0u, 0u}; const v4u hp = t0 > 0 ? *(const GAS v4u*)(HALO + (size_t)((tile - 1) * 2 + 1) * RWKV_COLS + col) : z; unpack8(prev, hp);
          unpack8(cur, *(const GAS v4u*)(UA + (size_t)row0 * RWKV_COLS + col)); }
        const v4u hn = (t0 + 64 < T) ? *(const GAS v4u*)(HALO + (size_t)((tile + 1) * 2) * RWKV_COLS + col) : (v4u){0u, 0u, 0u, 0u};
        for (int r0 = 0; r0 < 64; r0 += 4) {
            v4u nx[4];
#pragma unroll
            for (int k = 0; k < 4; ++k) { const int r = r0 + k + 1; nx[k] = (r < 64) ? *(const GAS v4u*)(UA + (size_t)(row0 + r) * RWKV_COLS + col) : hn; }
#pragma unroll
            for (int k = 0; k < 4; ++k) {
                float nf[8], o[8]; unpack8(nf, nx[k]);
#pragma unroll
                for (int i = 0; i < 8; ++i) { float x = cur[i] + mp[i] * (prev[i] - cur[i]) + mn[i] * (nf[i] - cur[i]); if (mode == 1) x = tanh_fast(x); else if (mode == 2) x = sigm_fast(x); o[i] = x; prev[i] = cur[i]; cur[i] = nf[i]; }
                v4u w; w.x = pk2(o[0], o[1]); w.y = pk2(o[2], o[3]); w.z = pk2(o[4], o[5]); w.w = pk2(o[6], o[7]);
                *(GAS v4u*)(UA + (size_t)(row0 + r0 + k) * RWKV_COLS + col) = w;
            }
        }
    }
}

constexpr int TC = 32, NBLK = TC / 2, BLKB = 2880;
constexpr int RECB = NBLK * BLKB;
constexpr int SC_REC = 0, SC_Y = 2 * RECB, SC_W2S = SC_Y + 2 * 8192, SC_A2S = SC_W2S + 9216, SC_PW = SC_A2S + 9216, PWB = 8704, SC_END = SC_PW + 4 * PWB;
constexpr int LSTR = 72;
static_assert(SC_END <= 162816, "scan LDS map");

template <int CTRL> __device__ __forceinline__ float dpp_mov(float x) { return __uint_as_float((unsigned)__builtin_amdgcn_mov_dpp((int)__float_as_uint(x), CTRL, 0xf, 0xf, true)); }
__device__ __forceinline__ float allsum8(float x) {
    x += dpp_mov<0xB1>(x);
    x += dpp_mov<0x4E>(x);
    x += dpp_mov<0x141>(x);
    return x;
}
__device__ __forceinline__ void allsum8x4(float& a, float& b, float& c, float& d) {
    a += dpp_mov<0xB1>(a); b += dpp_mov<0xB1>(b); c += dpp_mov<0xB1>(c); d += dpp_mov<0xB1>(d);
    a += dpp_mov<0x4E>(a); b += dpp_mov<0x4E>(b); c += dpp_mov<0x4E>(c); d += dpp_mov<0x4E>(d);
    a += dpp_mov<0x141>(a); b += dpp_mov<0x141>(b); c += dpp_mov<0x141>(c); d += dpp_mov<0x141>(d);
}
__device__ __forceinline__ float swap8(float x) { return dpp_mov<0x128>(x); }
__device__ __forceinline__ float dot8(const float (&s)[8], const f32x4 a, const f32x4 b) {
    return ((s[0] * a[0] + s[1] * a[1]) + (s[2] * a[2] + s[3] * a[3])) + ((s[4] * b[0] + s[5] * b[1]) + (s[6] * b[2] + s[7] * b[3]));
}

struct PairDots { f32x4 A1[2], A2[2], R1[2], R2[2]; };
__device__ __forceinline__ void pair_load(PairDots& o, const LAS unsigned char* rec, int qs) {
    const LAS f32x4* p = (const LAS f32x4*)rec + 2 * qs;
    o.A1[0] = p[0]; o.A1[1] = p[1]; o.A2[0] = p[16]; o.A2[1] = p[17]; o.R1[0] = p[32]; o.R1[1] = p[33]; o.R2[0] = p[48]; o.R2[1] = p[49];
}
template <int R>
__device__ __forceinline__ void pair_step(float (&S)[R][8], const PairDots& o, const LAS unsigned char* rec, LAS float* Yrec, int rowl, int qs) {
    const LAS f32x4* p = (const LAS f32x4*)rec + 2 * qs;
    f32x4 B1[2], K1[2], B2[2], K2[2], W12[2];
#pragma unroll
    for (int hh = 0; hh < 2; ++hh) { B1[hh] = p[64 + hh]; K1[hh] = p[80 + hh]; B2[hh] = p[96 + hh]; K2[hh] = p[112 + hh]; W12[hh] = p[128 + hh]; }
    const f32x4 c0 = *(const LAS f32x4*)(rec + 2816), c1 = *(const LAS f32x4*)(rec + 2832);
#pragma unroll
    for (int rho = 0; rho < R; ++rho) {
        const f32x2v v12 = *(const LAS f32x2v*)(rec + 2304 + (rowl + rho) * 8);
        float p1 = dot8(S[rho], o.A1[0], o.A1[1]), p2 = dot8(S[rho], o.A2[0], o.A2[1]), q1 = dot8(S[rho], o.R1[0], o.R1[1]), q2 = dot8(S[rho], o.R2[0], o.R2[1]);
        allsum8x4(p1, p2, q1, q2);
        float pre[8];
#pragma unroll
        for (int i = 0; i < 8; ++i) pre[i] = S[rho][i] * W12[i >> 2][i & 3] + (v12[0] * K1[i >> 2][i & 3] + v12[1] * K2[i >> 2][i & 3]);
        const float s1 = p1, s2 = p2 + (s1 * c0[2] + v12[0] * c0[3]);
#pragma unroll
        for (int i = 0; i < 8; ++i) S[rho][i] = pre[i] + (s1 * B1[i >> 2][i & 3] + s2 * B2[i >> 2][i & 3]);
        const float y1 = q1 + (s1 * c0[0] + v12[0] * c0[1]);
        const float y2 = q2 + (s1 * c1[0] + v12[0] * c1[1]) + (s2 * c1[2] + v12[1] * c1[3]);
        if (qs == 0) *(LAS f32x2v*)(Yrec + (rowl + rho) * 2) = (f32x2v){y1, y2};
    }
}

struct PrepRaw { v4u r, k, v, th, xa; };
__device__ __forceinline__ void prep_load(PrepRaw& raw, const bf16* UA, int row0, int T, int d, int step, int h, int q8) {
    const int t = d ? (T - 1 - step) : step; const bf16* rowp = UA + (size_t)(row0 + t) * RWKV_COLS;
    raw.r = *(const GAS v4u*)(rowp + h * 64 + q8); raw.k = *(const GAS v4u*)(rowp + 512 + h * 64 + q8); raw.v = *(const GAS v4u*)(rowp + 1024 + h * 64 + q8);
    raw.th = *(const GAS v4u*)(rowp + 1536 + q8); raw.xa = *(const GAS v4u*)(rowp + 1600 + q8);
}

__device__ __forceinline__ void prep_chunk(const PrepRaw& raw, LAS unsigned char* REC, LAS unsigned char* PW, const LAS bf16* W2S, const LAS bf16* A2S, int pw, int lane,
                                           const float (&zw0)[4], const float (&za0)[4], const float (&kk8)[8], const float (&ka8)[8], const float (&rk8)[8], float* bonus_dst) {
    const int st = lane >> 3, q8 = (lane & 7) * 8, c16 = lane & 15, kq = lane >> 4;
    LAS bf16* TH = (LAS bf16*)PW; LAS bf16* XA = (LAS bf16*)(PW + 2304); LAS float* ZW = (LAS float*)(PW + 4608); LAS float* ZA = ZW + 512;
    *(LAS v4u*)(TH + st * LSTR + q8) = raw.th; *(LAS v4u*)(XA + st * LSTR + q8) = raw.xa;
    asm volatile("s_waitcnt lgkmcnt(0)" ::: "memory");
#pragma unroll
    for (int nt = 0; nt < 4; ++nt) {
        f32x4 aw = {0.f, 0.f, 0.f, 0.f}, aa = {0.f, 0.f, 0.f, 0.f};
#pragma unroll
        for (int ks = 0; ks < 2; ++ks) {
            const bf16x8 xt = *(const LAS bf16x8*)(TH + c16 * LSTR + ks * 32 + kq * 8), xx = *(const LAS bf16x8*)(XA + c16 * LSTR + ks * 32 + kq * 8);
            const bf16x8 bw = *(const LAS bf16x8*)(W2S + (16 * nt + c16) * LSTR + ks * 32 + kq * 8), ba = *(const LAS bf16x8*)(A2S + (16 * nt + c16) * LSTR + ks * 32 + kq * 8);
            aw = __builtin_amdgcn_mfma_f32_16x16x32_bf16(xt, bw, aw, 0, 0, 0);
            aa = __builtin_amdgcn_mfma_f32_16x16x32_bf16(xx, ba, aa, 0, 0, 0);
        }
        if (kq < 2) {
#pragma unroll
            for (int i = 0; i < 4; ++i) { ZW[(4 * kq + i) * 64 + 16 * nt + c16] = aw[i] + zw0[nt]; ZA[(4 * kq + i) * 64 + 16 * nt + c16] = aa[i] + za0[nt]; }
        }
    }
    asm volatile("s_waitcnt lgkmcnt(0)" ::: "memory");
    float w[8], as[8];
    { const f32x4 z0 = *(const LAS f32x4*)(ZW + st * 64 + q8), z1 = *(const LAS f32x4*)(ZW + st * 64 + q8 + 4), y0 = *(const LAS f32x4*)(ZA + st * 64 + q8), y1 = *(const LAS f32x4*)(ZA + st * 64 + q8 + 4);
#pragma unroll
      for (int i = 0; i < 4; ++i) { w[i] = __expf(-0.6065306597126334f * sigm_fast(z0[i])); w[4 + i] = __expf(-0.6065306597126334f * sigm_fast(z1[i])); as[i] = sigm_fast(y0[i]); as[4 + i] = sigm_fast(y1[i]); } }
    float r[8], k[8], v[8]; unpack8(r, raw.r); unpack8(k, raw.k); unpack8(v, raw.v);
    float kk0[8], ss = 0.f;
#pragma unroll
    for (int i = 0; i < 8; ++i) { kk0[i] = k[i] * kk8[i]; ss += kk0[i] * kk0[i]; }
    ss = allsum8(ss);
    const float inv = 1.0f / fmaxf(sqrtf(ss), 1e-12f);
    float kd[8], a[8], b[8], bon = 0.f;
#pragma unroll
    for (int i = 0; i < 8; ++i) { const float kk = kk0[i] * inv; kd[i] = k[i] * (1.0f + (as[i] - 1.0f) * ka8[i]); a[i] = -kk; b[i] = kk * as[i]; bon += r[i] * kd[i] * rk8[i]; }
    float pb[8], pk[8], wp[8];
#pragma unroll
    for (int i = 0; i < 8; ++i) { pb[i] = swap8(b[i]); pk[i] = swap8(kd[i]); wp[i] = swap8(w[i]); }
    float d1 = 0.f, d2 = 0.f, d3 = 0.f, d4 = 0.f, d5 = 0.f, d6 = 0.f;
#pragma unroll
    for (int i = 0; i < 8; ++i) { d1 += b[i] * r[i]; d2 += kd[i] * r[i]; d3 += pb[i] * a[i]; d4 += pk[i] * a[i]; const float wr = w[i] * r[i]; d5 += pb[i] * wr; d6 += pk[i] * wr; }
    allsum8x4(d1, d2, d3, d4); allsum8x4(d5, d6, bon, ss);
    const int odd = st & 1; LAS unsigned char* rec = REC + (4 * pw + (st >> 1)) * BLKB; LAS f32x4* vec = (LAS f32x4*)rec + 2 * (lane & 7);
    if (!odd) {
#pragma unroll
        for (int hh = 0; hh < 2; ++hh) { f32x4 x0, x1, x2, x3, x4;
#pragma unroll
            for (int i = 0; i < 4; ++i) { const int e = 4 * hh + i; x0[i] = a[e]; x1[i] = w[e] * r[e]; x2[i] = b[e] * wp[e]; x3[i] = kd[e] * wp[e]; x4[i] = w[e] * wp[e]; }
            vec[0 + hh] = x0; vec[32 + hh] = x1; vec[64 + hh] = x2; vec[80 + hh] = x3; vec[128 + hh] = x4; }
    } else {
#pragma unroll
        for (int hh = 0; hh < 2; ++hh) { f32x4 x0, x1, x2, x3;
#pragma unroll
            for (int i = 0; i < 4; ++i) { const int e = 4 * hh + i; x0[i] = wp[e] * a[e]; x1[i] = (wp[e] * w[e]) * r[e]; x2[i] = b[e]; x3[i] = kd[e]; }
            vec[16 + hh] = x0; vec[48 + hh] = x1; vec[96 + hh] = x2; vec[112 + hh] = x3; }
    }
    LAS float* v2p = (LAS float*)(rec + 2304) + q8 * 2 + odd;
#pragma unroll
    for (int i = 0; i < 8; ++i) v2p[2 * i] = v[i];
    if ((lane & 7) == 0) { LAS float* cf = (LAS float*)(rec + 2816);
        if (!odd) { cf[0] = d1; cf[1] = d2; } else { cf[2] = d3; cf[3] = d4; cf[4] = d5; cf[5] = d6; cf[6] = d1; cf[7] = d2; }
        if (bonus_dst) *bonus_dst = bon; }
}

template <int R>
__device__ __forceinline__ void scan_chain(LAS unsigned char* L, const bf16* UA, const float* const* in, bf16* Yd, float* BONUS, int d, int s, int h, int rbase, bool write_bonus) {
    const int tid = threadIdx.x, lane = tid & 63, wave = __builtin_amdgcn_readfirstlane(tid >> 6);
    int row0, T; seq_geom(s, row0, T);
    const int NCH = T / TC;
    const float* w0 = in[9]; const float* w2 = in[10]; const float* a0 = in[11]; const float* a2 = in[12]; const float* k_k = in[14]; const float* k_a = in[15]; const float* r_k = in[16];
    LAS bf16* W2S = (LAS bf16*)(L + SC_W2S); LAS bf16* A2S = (LAS bf16*)(L + SC_A2S); LAS float* Yl = (LAS float*)(L + SC_Y);
    __syncthreads();
    { const int j = tid >> 3, c8 = (tid & 7) * 8;
      const float* wsrc = w2 + ((size_t)d * 64 + j) * 512 + h * 64 + c8; const float* asrc = a2 + ((size_t)d * 64 + j) * 512 + h * 64 + c8;
#pragma unroll
      for (int i = 0; i < 8; ++i) { W2S[(c8 + i) * LSTR + j] = (bf16)f2bf(wsrc[i]); A2S[(c8 + i) * LSTR + j] = (bf16)f2bf(asrc[i]); } }
    __syncthreads();
    if (wave < 4) {
        const int g = lane >> 3, qs = lane & 7, rowl = rbase + wave * 8 * R + g * R;
        float S[R][8];
#pragma unroll
        for (int rho = 0; rho < R; ++rho)
#pragma unroll
            for (int i = 0; i < 8; ++i) S[rho][i] = 0.f;
        for (int c = 0; c < NCH; ++c) {
            asm volatile("s_waitcnt lgkmcnt(0)" ::: "memory"); __builtin_amdgcn_s_barrier(); asm volatile("" ::: "memory");
            const LAS unsigned char* REC = L + SC_REC + (c & 1) * RECB; LAS float* Yc = Yl + (c & 1) * 2048;
            PairDots oa, ob; pair_load(oa, REC, qs);
#pragma unroll 1
            for (int bp = 0; bp < NBLK; bp += 2) {
                pair_load(ob, REC + (bp + 1) * BLKB, qs);
                pair_step<R>(S, oa, REC + bp * BLKB, Yc + bp * 128, rowl, qs);
                pair_load(oa, REC + ((bp + 2) & (NBLK - 1)) * BLKB, qs);
                pair_step<R>(S, ob, REC + (bp + 1) * BLKB, Yc + (bp + 1) * 128, rowl, qs);
            }
        }
        asm volatile("s_waitcnt lgkmcnt(0)" ::: "memory"); __builtin_amdgcn_s_barrier(); asm volatile("" ::: "memory");
    } else {
        const int pw = wave - 4, st = lane >> 3, q8 = (lane & 7) * 8, c16 = lane & 15;
        LAS unsigned char* PW = L + SC_PW + pw * PWB;
        float zw0[4], za0[4], kk8[8], ka8[8], rk8[8];
#pragma unroll
        for (int nt = 0; nt < 4; ++nt) { zw0[nt] = w0[d * 512 + h * 64 + 16 * nt + c16]; za0[nt] = a0[d * 512 + h * 64 + 16 * nt + c16]; }
#pragma unroll
        for (int i = 0; i < 8; ++i) { kk8[i] = k_k[h * 64 + q8 + i]; ka8[i] = k_a[h * 64 + q8 + i]; rk8[i] = r_k[h * 64 + q8 + i]; }
        PrepRaw raw; prep_load(raw, UA, row0, T, d, 8 * pw + st, h, q8);
        {
            const int step = 8 * pw + st, t = d ? (T - 1 - step) : step;
            float* bd = (write_bonus && (lane & 7) == 0) ? BONUS + (size_t)d * NTOK * 8 + (size_t)(row0 + t) * 8 + h : nullptr;
            prep_chunk(raw, L + SC_REC, PW, W2S, A2S, pw, lane, zw0, za0, kk8, ka8, rk8, bd);
        }
        if (NCH > 1) prep_load(raw, UA, row0, T, d, TC + 8 * pw + st, h, q8);
        for (int c = 0; c < NCH; ++c) {
            asm volatile("s_waitcnt lgkmcnt(0)" ::: "memory"); __builtin_amdgcn_s_barrier(); asm volatile("" ::: "memory");
            if (c > 0) {
                const int step = (c - 1) * TC + 8 * pw + st, t = d ? (T - 1 - step) : step; const int cc = rbase + (lane & 7) * 4 * R;
                const LAS float* ys = Yl + ((c - 1) & 1) * 2048 + (4 * pw + (st >> 1)) * 128 + (st & 1);
                bf16* dstp = Yd + (size_t)(row0 + t) * 512 + h * 64 + cc;
                if (R == 2) { v4u o; o.x = pk2(ys[cc * 2], ys[(cc + 1) * 2]); o.y = pk2(ys[(cc + 2) * 2], ys[(cc + 3) * 2]); o.z = pk2(ys[(cc + 4) * 2], ys[(cc + 5) * 2]); o.w = pk2(ys[(cc + 6) * 2], ys[(cc + 7) * 2]); *(GAS v4u*)dstp = o; }
                else { v2u o; o.x = pk2(ys[cc * 2], ys[(cc + 1) * 2]); o.y = pk2(ys[(cc + 2) * 2], ys[(cc + 3) * 2]); *(GAS v2u*)dstp = o; }
            }
            if (c + 1 < NCH) {
                const int step = (c + 1) * TC + 8 * pw + st, t = d ? (T - 1 - step) : step;
                float* bd = (write_bonus && (lane & 7) == 0) ? BONUS + (size_t)d * NTOK * 8 + (size_t)(row0 + t) * 8 + h : nullptr;
                prep_chunk(raw, L + SC_REC + ((c + 1) & 1) * RECB, PW, W2S, A2S, pw, lane, zw0, za0, kk8, ka8, rk8, bd);
                if (c + 2 < NCH) prep_load(raw, UA, row0, T, d, (c + 2) * TC + 8 * pw + st, h, q8);
            }
        }
        asm volatile("s_waitcnt lgkmcnt(0)" ::: "memory"); __builtin_amdgcn_s_barrier(); asm volatile("" ::: "memory");
        {
            const int step = (NCH - 1) * TC + 8 * pw + st, t = d ? (T - 1 - step) : step; const int cc = rbase + (lane & 7) * 4 * R;
            const LAS float* ys = Yl + ((NCH - 1) & 1) * 2048 + (4 * pw + (st >> 1)) * 128 + (st & 1);
            bf16* dstp = Yd + (size_t)(row0 + t) * 512 + h * 64 + cc;
            if (R == 2) { v4u o; o.x = pk2(ys[cc * 2], ys[(cc + 1) * 2]); o.y = pk2(ys[(cc + 2) * 2], ys[(cc + 3) * 2]); o.z = pk2(ys[(cc + 4) * 2], ys[(cc + 5) * 2]); o.w = pk2(ys[(cc + 6) * 2], ys[(cc + 7) * 2]); *(GAS v4u*)dstp = o; }
            else { v2u o; o.x = pk2(ys[cc * 2], ys[(cc + 1) * 2]); o.y = pk2(ys[(cc + 2) * 2], ys[(cc + 3) * 2]); *(GAS v2u*)dstp = o; }
        }
    }
}

__device__ __forceinline__ void scan_phase(LAS unsigned char* L, const bf16* UA, const float* const* in, bf16* YF, bf16* YBW, float* BONUS, int bx, int G) {
    for (int wi = bx; wi < 256; wi += G) {
        if (wi < 128) { const int d = wi >> 6, rem = wi & 63, s = 4 + (rem >> 3), h = rem & 7; scan_chain<2>(L, UA, in, d ? YBW : YF, BONUS, d, s, h, 0, true); }
        else { const int pc = (wi - 128) >> 1, half = (wi - 128) & 1, d = pc >> 5, rem = pc & 31, s = rem >> 3, h = rem & 7; scan_chain<1>(L, UA, in, d ? YBW : YF, BONUS, d, s, h, 32 * half, half == 0); }
    }
}

constexpr int PO_SG = 0, PSTR = 136;
__device__ __forceinline__ void post_phase(LAS unsigned char* L, const bf16* UA, const float* const* in, const bf16* G2T, const bf16* YF, const bf16* YBW, const float* BONUS, bf16* YA, int vcu, int G) {
    const int tid = threadIdx.x, lane = tid & 63, wave = __builtin_amdgcn_readfirstlane(tid >> 6), r32 = lane & 31, hi = lane >> 5;
    const float* lnx_g = in[17]; const float* lnx_b = in[18];
    LAS bf16* SG = (LAS bf16*)(L + PO_SG);
    for (int unit = vcu; unit < NTOK / 64; unit += G) {
        const int m0 = unit * 64;
        __syncthreads();
        {
            const int i = tid >> 3, j16 = (tid & 7) * 16, m = m0 + i;
#pragma unroll
            for (int hf = 0; hf < 2; ++hf) *(LAS v4u*)(SG + i * PSTR + j16 + 8 * hf) = *(const GAS v4u*)(UA + (size_t)m * RWKV_COLS + 1664 + j16 + 8 * hf);
        }
        __syncthreads();
        f32x16 acc[2][2];
#pragma unroll
        for (int mt = 0; mt < 2; ++mt)
#pragma unroll
            for (int nt = 0; nt < 2; ++nt)
#pragma unroll
                for (int e = 0; e < 16; ++e) acc[mt][nt][e] = 0.f;
#pragma unroll
        for (int ks = 0; ks < 8; ++ks) {
            bf16x8 af[2], bfr[2];
#pragma unroll
            for (int mt = 0; mt < 2; ++mt) af[mt] = *(const LAS bf16x8*)(SG + (32 * mt + r32) * PSTR + ks * 16 + hi * 8);
#pragma unroll
            for (int nt = 0; nt < 2; ++nt) bfr[nt] = *(const GAS bf16x8*)(G2T + (size_t)(64 * wave + 32 * nt + r32) * 128 + ks * 16 + hi * 8);
#pragma unroll
            for (int mt = 0; mt < 2; ++mt)
#pragma unroll
                for (int nt = 0; nt < 2; ++nt) acc[mt][nt] = __builtin_amdgcn_mfma_f32_32x32x16_bf16(af[mt], bfr[nt], acc[mt][nt], 0, 0, 0);
        }
        const int c0 = 64 * wave + r32;
        const float lg0 = lnx_g[c0], lg1 = lnx_g[c0 + 32], lb0 = lnx_b[c0], lb1 = lnx_b[c0 + 32];
#pragma unroll
        for (int mt = 0; mt < 2; ++mt)
#pragma unroll
            for (int e = 0; e < 16; ++e) {
                const int i = 32 * mt + (e & 3) + 8 * (e >> 2) + 4 * hi, m = m0 + i;
                const float y0 = bf2f(YF[(size_t)m * 512 + c0]) + bf2f(YBW[(size_t)m * 512 + c0]), y1 = bf2f(YF[(size_t)m * 512 + c0 + 32]) + bf2f(YBW[(size_t)m * 512 + c0 + 32]);
                float sm = y0 + y1;
                sm += __shfl_xor(sm, 1); sm += __shfl_xor(sm, 2); sm += __shfl_xor(sm, 4); sm += __shfl_xor(sm, 8); sm += __shfl_xor(sm, 16);
                const float mean = sm * (1.f / 64.f), d0 = y0 - mean, d1 = y1 - mean;
                float sq = d0 * d0 + d1 * d1;
                sq += __shfl_xor(sq, 1); sq += __shfl_xor(sq, 2); sq += __shfl_xor(sq, 4); sq += __shfl_xor(sq, 8); sq += __shfl_xor(sq, 16);
                const float rstd = 1.0f / sqrtf(sq * (1.f / 64.f) + 64e-5f);
                const float bonus = BONUS[(size_t)m * 8 + wave] + BONUS[(size_t)NTOK * 8 + (size_t)m * 8 + wave];
                const bf16* vp = UA + 1024 + c0;
                const float vs0 = bf2f(vp[(size_t)m * RWKV_COLS]), vs1 = bf2f(vp[(size_t)m * RWKV_COLS + 32]);
                const float o0 = (d0 * rstd * lg0 + lb0 + bonus * vs0) * acc[mt][0][e], o1 = (d1 * rstd * lg1 + lb1 + bonus * vs1) * acc[mt][1][e];
                YA[(size_t)m * 512 + c0] = (bf16)f2bf(o0); YA[(size_t)m * 512 + c0 + 32] = (bf16)f2bf(o1);
            }
    }
}

constexpr int RSTR = 136;
constexpr int RT_A = 0, RT_B = 34816, RT_C = 69632;
__device__ __forceinline__ float ret_lg(int h) { return log2f(1.0f - exp2f(-5.0f - (float)h)); }

__device__ __forceinline__ void ret_stage_T(LAS bf16* dst, const bf16* src, int tid, float f0, float f1) {
    const int jp = tid & 63, dq = (tid >> 6) * 16;
    const v4u a0 = *(const GAS v4u*)(src + (size_t)(2 * jp) * RET_COLS + dq), a1 = *(const GAS v4u*)(src + (size_t)(2 * jp) * RET_COLS + dq + 8);
    const v4u b0 = *(const GAS v4u*)(src + (size_t)(2 * jp + 1) * RET_COLS + dq), b1 = *(const GAS v4u*)(src + (size_t)(2 * jp + 1) * RET_COLS + dq + 8);
    const unsigned aw[8] = {a0.x, a0.y, a0.z, a0.w, a1.x, a1.y, a1.z, a1.w}, bw[8] = {b0.x, b0.y, b0.z, b0.w, b1.x, b1.y, b1.z, b1.w};
#pragma unroll
    for (int e = 0; e < 8; ++e) {
        *(LAS unsigned*)(dst + (dq + 2 * e) * RSTR + 2 * jp) = pk2(bflo(aw[e]) * f0, bflo(bw[e]) * f1);
        *(LAS unsigned*)(dst + (dq + 2 * e + 1) * RSTR + 2 * jp) = pk2(bfhi(aw[e]) * f0, bfhi(bw[e]) * f1);
    }
}
__device__ __forceinline__ void ret_stage_N(LAS bf16* dst, const bf16* src, int tid) {
    const int i = tid >> 2, sg = (tid & 3) * 32;
#pragma unroll
    for (int e = 0; e < 4; ++e) *(LAS v4u*)(dst + i * RSTR + sg + 8 * e) = *(const GAS v4u*)(src + (size_t)i * RET_COLS + sg + 8 * e);
}

__device__ __forceinline__ void ret_kv_phase(LAS unsigned char* L, const bf16* UR, bf16* KV, int vcu, int G) {
    const int tid = threadIdx.x, lane = tid & 63, wave = __builtin_amdgcn_readfirstlane(tid >> 6), r32 = lane & 31, hi = lane >> 5;
    LAS bf16* VT = (LAS bf16*)(L + RT_A); LAS bf16* KfT = (LAS bf16*)(L + RT_B); LAS bf16* KbT = (LAS bf16*)(L + RT_C);
    const int eb = wave & 3, dh = wave >> 2;
    for (int unit = vcu; unit < 1024; unit += G) {
        const int cidx = unit >> 2, h = unit & 3, m0 = cidx * 128; const float lg = ret_lg(h);
        __syncthreads();
        const int jp = tid & 63; const float j0 = (float)(2 * jp);
        ret_stage_T(VT, UR + (size_t)m0 * RET_COLS + 1024 + h * 128, tid, 1.0f, 1.0f);
        ret_stage_T(KfT, UR + (size_t)m0 * RET_COLS + 512 + h * 128, tid, exp2f(lg * (127.0f - j0)), exp2f(lg * (126.0f - j0)));
        ret_stage_T(KbT, UR + (size_t)m0 * RET_COLS + 512 + h * 128, tid, exp2f(lg * j0), exp2f(lg * (j0 + 1.0f)));
        __syncthreads();
        f32x16 acc[2][2];
#pragma unroll
        for (int a = 0; a < 2; ++a)
#pragma unroll
            for (int b = 0; b < 2; ++b)
#pragma unroll
                for (int e = 0; e < 16; ++e) acc[a][b][e] = 0.f;
#pragma unroll
        for (int ks = 0; ks < 8; ++ks) {
            const bf16x8 af = *(const LAS bf16x8*)(VT + (32 * eb + r32) * RSTR + ks * 16 + hi * 8);
#pragma unroll
            for (int nt = 0; nt < 2; ++nt) {
                const bf16x8 bf_ = *(const LAS bf16x8*)(KfT + (64 * dh + 32 * nt + r32) * RSTR + ks * 16 + hi * 8);
                const bf16x8 bb_ = *(const LAS bf16x8*)(KbT + (64 * dh + 32 * nt + r32) * RSTR + ks * 16 + hi * 8);
                acc[0][nt] = __builtin_amdgcn_mfma_f32_32x32x16_bf16(af, bf_, acc[0][nt], 0, 0, 0);
                acc[1][nt] = __builtin_amdgcn_mfma_f32_32x32x16_bf16(af, bb_, acc[1][nt], 0, 0, 0);
            }
        }
#pragma unroll
        for (int dir = 0; dir < 2; ++dir)
#pragma unroll
            for (int nt = 0; nt < 2; ++nt)
#pragma unroll
                for (int q = 0; q < 16; ++q) { const int e = 32 * eb + (q & 3) + 8 * (q >> 2) + 4 * hi, dd = 64 * dh + 32 * nt + r32;
                    KV[((size_t)(cidx * 4 + h) * 2 + dir) * 16384 + e * 128 + dd] = (bf16)f2bf(acc[dir][nt][q]); }
    }
}

__device__ __forceinline__ void ret_scan_phase(bf16* KV, int gtid, int NGT) {
    for (int it = gtid; it < 96 * 2048; it += NGT) {
        const int chain = it >> 11, e8 = (it & 2047) * 8; const int s = chain >> 3, h = (chain >> 1) & 3, dir = chain & 1;
        int row0, T; seq_geom(s, row0, T); const int c0 = row0 >> 7, NC = T >> 7;
        const float dec = exp2f(128.0f * ret_lg(h));
        float R[8];
#pragma unroll
        for (int i = 0; i < 8; ++i) R[i] = 0.f;
#pragma unroll 4
        for (int k = 0; k < NC; ++k) {
            const int n = dir ? (NC - 1 - k) : k;
            GAS v4u* p = (GAS v4u*)(KV + ((size_t)((c0 + n) * 4 + h) * 2 + dir) * 16384 + e8);
            const v4u w = *p; const unsigned ww[4] = {w.x, w.y, w.z, w.w};
            v4u o; o.x = pk2(R[0], R[1]); o.y = pk2(R[2], R[3]); o.z = pk2(R[4], R[5]); o.w = pk2(R[6], R[7]);
            *p = o;
#pragma unroll
            for (int i = 0; i < 4; ++i) { R[2 * i] = dec * R[2 * i] + bflo(ww[i]); R[2 * i + 1] = dec * R[2 * i + 1] + bfhi(ww[i]); }
        }
    }
}

__device__ __forceinline__ void ret_out_phase(LAS unsigned char* L, const bf16* UR, const bf16* KV, bf16* YB, int vcu, int G) {
    const int tid = threadIdx.x, lane = tid & 63, wave = __builtin_amdgcn_readfirstlane(tid >> 6), r32 = lane & 31, hi = lane >> 5;
    LAS bf16* Qs = (LAS bf16*)(L + RT_A); LAS bf16* Ks = (LAS bf16*)(L + RT_B); LAS bf16* VT = (LAS bf16*)(L + RT_C); LAS bf16* Ps = Qs;
    LAS float* Os = (LAS float*)(L + RT_A);
    const int ib = wave & 3, half = wave >> 2;
    for (int unit = vcu; unit < 1024; unit += G) {
        const int cidx = unit >> 2, h = unit & 3, m0 = cidx * 128; const float lg = ret_lg(h);
        __syncthreads();
        ret_stage_N(Qs, UR + (size_t)m0 * RET_COLS + h * 128, tid);
        ret_stage_N(Ks, UR + (size_t)m0 * RET_COLS + 512 + h * 128, tid);
        ret_stage_T(VT, UR + (size_t)m0 * RET_COLS + 1024 + h * 128, tid, 1.0f, 1.0f);
        __syncthreads();
        f32x16 af_[2], ab_[2], as_[2];
#pragma unroll
        for (int nt = 0; nt < 2; ++nt)
#pragma unroll
            for (int e = 0; e < 16; ++e) { af_[nt][e] = 0.f; ab_[nt][e] = 0.f; as_[nt][e] = 0.f; }
        const bf16* stf = KV + ((size_t)(cidx * 4 + h) * 2 + 0) * 16384; const bf16* stb = stf + 16384;
#pragma unroll
        for (int ks = 0; ks < 8; ++ks) {
            const bf16x8 qf = *(const LAS bf16x8*)(Qs + (32 * ib + r32) * RSTR + ks * 16 + hi * 8);
#pragma unroll
            for (int nt = 0; nt < 2; ++nt) {
                const int col = 64 * half + 32 * nt + r32;
                const bf16x8 sf = *(const GAS bf16x8*)(stf + (size_t)col * 128 + ks * 16 + hi * 8);
                const bf16x8 sb = *(const GAS bf16x8*)(stb + (size_t)col * 128 + ks * 16 + hi * 8);
                const bf16x8 kf = *(const LAS bf16x8*)(Ks + col * RSTR + ks * 16 + hi * 8);
                af_[nt] = __builtin_amdgcn_mfma_f32_32x32x16_bf16(qf, sf, af_[nt], 0, 0, 0);
                ab_[nt] = __builtin_amdgcn_mfma_f32_32x32x16_bf16(qf, sb, ab_[nt], 0, 0, 0);
                as_[nt] = __builtin_amdgcn_mfma_f32_32x32x16_bf16(qf, kf, as_[nt], 0, 0, 0);
            }
        }
        __syncthreads();
#pragma unroll
        for (int nt = 0; nt < 2; ++nt)
#pragma unroll
            for (int q = 0; q < 16; ++q) { const int i = 32 * ib + (q & 3) + 8 * (q >> 2) + 4 * hi, j = 64 * half + 32 * nt + r32;
                Ps[i * RSTR + j] = (bf16)f2bf(as_[nt][q] * exp2f(lg * fabsf((float)(i - j)))); }
        __syncthreads();
        f32x16 ao_[2];
#pragma unroll
        for (int nt = 0; nt < 2; ++nt)
#pragma unroll
            for (int e = 0; e < 16; ++e) ao_[nt][e] = 0.f;
#pragma unroll
        for (int ks = 0; ks < 8; ++ks) {
            const bf16x8 pf = *(const LAS bf16x8*)(Ps + (32 * ib + r32) * RSTR + ks * 16 + hi * 8);
#pragma unroll
            for (int nt = 0; nt < 2; ++nt) {
                const bf16x8 vf = *(const LAS bf16x8*)(VT + (64 * half + 32 * nt + r32) * RSTR + ks * 16 + hi * 8);
                ao_[nt] = __builtin_amdgcn_mfma_f32_32x32x16_bf16(pf, vf, ao_[nt], 0, 0, 0);
            }
        }
        __syncthreads();
#pragma unroll
        for (int nt = 0; nt < 2; ++nt)
#pragma unroll
            for (int q = 0; q < 16; ++q) { const int i = 32 * ib + (q & 3) + 8 * (q >> 2) + 4 * hi, e = 64 * half + 32 * nt + r32;
                Os[i * 132 + e] = ao_[nt][q] + exp2f(lg * (float)(i + 1)) * af_[nt][q] + exp2f(lg * (float)(128 - i)) * ab_[nt][q]; }
        __syncthreads();
        {
            const int i = tid >> 2, part = (tid & 3) * 32; float v[32], sm = 0.f;
#pragma unroll
            for (int e = 0; e < 8; ++e) { const f32x4 x = *(const LAS f32x4*)(Os + i * 132 + part + 4 * e); v[4 * e] = x[0]; v[4 * e + 1] = x[1]; v[4 * e + 2] = x[2]; v[4 * e + 3] = x[3]; sm += (x[0] + x[1]) + (x[2] + x[3]); }
            sm += __shfl_xor(sm, 1); sm += __shfl_xor(sm, 2);
            const float mean = sm * (1.f / 128.f); float sq = 0.f;
#pragma unroll
            for (int e = 0; e < 32; ++e) { v[e] -= mean; sq += v[e] * v[e]; }
            sq += __shfl_xor(sq, 1); sq += __shfl_xor(sq, 2);
            const float rstd = 1.0f / sqrtf(sq * (1.f / 128.f) + 1e-6f);
            const bf16* gp = UR + (size_t)(m0 + i) * RET_COLS + 1536 + h * 128 + part; bf16* op = YB + (size_t)(m0 + i) * 512 + h * 128 + part;
#pragma unroll
            for (int e = 0; e < 4; ++e) { const v4u gw_ = *(const GAS v4u*)(gp + 8 * e); const unsigned gwv[4] = {gw_.x, gw_.y, gw_.z, gw_.w}; unsigned ow[4];
#pragma unroll
                for (int p = 0; p < 4; ++p) { const float g0 = bflo(gwv[p]), g1 = bfhi(gwv[p]);
                    ow[p] = pk2(g0 * sigm(g0) * v[8 * e + 2 * p] * rstd, g1 * sigm(g1) * v[8 * e + 2 * p + 1] * rstd); }
                v4u o; o.x = ow[0]; o.y = ow[1]; o.z = ow[2]; o.w = ow[3]; *(GAS v4u*)(op + 8 * e) = o; }
        }
    }
}

struct Args { const float* in[28]; float* out; unsigned char* ws; int ph_lo, ph_hi, li, pad; };
constexpr int N_PHASES = 21;

__global__ void __launch_bounds__(NWAVES * 64, 2) mk(Args args) {
    extern __shared__ __attribute__((aligned(16))) unsigned char lds[];
    LAS unsigned char* L = (LAS unsigned char*)lds;
    volatile LAS unsigned* MISC = (volatile LAS unsigned*)(L + MISC_OFF);
    const int tid = threadIdx.x, lane = tid & 63, wave = __builtin_amdgcn_readfirstlane(tid >> 6);
    const int G = gridDim.x; const int bx = blockIdx.x; const int vcu = (G % 8 == 0) ? (bx % 8) * (G / 8) + bx / 8 : bx;
    unsigned char* ws = args.ws; unsigned char* dout = (unsigned char*)args.out;
    gu32* ctl = (gu32*)(ws + WS_CTL);
    for (int u = tid; u < (LDS_BYTES - LDSCTL_OFF) / 4; u += NWAVES * 64) ((LAS unsigned*)(L + LDSCTL_OFF))[u] = 0u;
    __syncthreads();
    const int lo = args.ph_lo, hi = args.ph_hi;
    const bool use_bar = (hi - lo) > 1;
    XcdBarrier bar; bar.bar = (unsigned*)(ctl + CW_BAR) + args.li * XCD_BAR_WORDS; bar.x = 0; bar.st = nullptr;
    if (use_bar) bar = xcd_barrier_post((unsigned*)(ctl + CW_BAR) + args.li * XCD_BAR_WORDS, MISC + 8);
#define IN(k) (lo <= (k) && (k) < hi)
#define SEAM(k) do { if (IN(k) && IN((k) + 1)) xcd_barrier(bar); } while (0)
    const int gw = vcu * NWAVES + wave, NGW = G * NWAVES;
    const int gtid = vcu * (NWAVES * 64) + tid, NGT = G * NWAVES * 64;
    const float* xp = args.in[0]; const float* xs = args.in[1];
    bf16* W_UP1 = (bf16*)(ws + WS_W_UP1); bf16* W_DN1 = (bf16*)(ws + WS_W_DN1); bf16* W_IN = (bf16*)(ws + WS_W_IN);
    bf16* W_BR = (bf16*)(ws + WS_W_BR); bf16* W_OUT = (bf16*)(ws + WS_W_OUT); bf16* W_UP2 = (bf16*)(ws + WS_W_UP2); bf16* W_DN2 = (bf16*)(ws + WS_W_DN2);
    float2* TAB = (float2*)(ws + WS_TAB);
    bf16* XB = (bf16*)(dout + DO_XB); bf16* X1B = (bf16*)(ws + WS_X1B); bf16* X2B = (bf16*)(ws + WS_X2B);
    bf16* H1 = (bf16*)(ws + WS_H1); bf16* H2 = (bf16*)(ws + WS_H2);
    bf16* UR = (bf16*)(ws + WS_BIG); bf16* UA = (bf16*)(ws + WS_BIG); bf16* HB = (bf16*)(ws + WS_BIG);
    bf16* YA = (bf16*)(dout + DO_YA); bf16* YB = (bf16*)(dout + DO_YB);
    float* PF = args.out;

    if (IN(0)) {
        LAS float* scr = (LAS float*)(L + RING_OFF + wave * 16384);
        constexpr int I_UP = 16 * 176, I_DN = 44 * 32, I_IN = 16 * 184, I_BR = 8 * 32, I_OUT = 16 * 32;
        constexpr int I_G2 = 2 * 16; constexpr int NITEMS = 2 * I_UP + I_DN + I_IN + 2 * I_BR + 2 * I_OUT + I_G2;
        for (int it = gw; it < NITEMS; it += NGW) {
            int r = it;
            if (r < I_UP) { p0_transpose_item(args.in[2], 2 * DFF, W_UP1, DM, 0, 0, 1, scr, r, lane); continue; } r -= I_UP;
            if (r < I_UP) { p0_transpose_item(args.in[24], 2 * DFF, W_UP2, DM, 0, 0, 1, scr, r, lane); continue; } r -= I_UP;
            if (r < I_DN) { p0_transpose_item(args.in[3], DM, W_DN1, DFF, 0, 0, 0, scr, r, lane); continue; } r -= I_DN;
            if (r < I_IN) { p0_transpose_item(args.in[6], IN_COLS, W_IN, DM, 0, 0, 0, scr, r, lane); continue; } r -= I_IN;
            if (r < I_BR) { p0_transpose_item(args.in[19], DM, W_BR, 512, 0, 0, 0, scr, r, lane); continue; } r -= I_BR;
            if (r < I_BR) { p0_transpose_item(args.in[20], DM, W_BR, 512, 0, 1024, 0, scr, r, lane); continue; } r -= I_BR;
            if (r < I_OUT) { p0_transpose_item(args.in[21], DM, W_OUT, 2048, 0, 0, 0, scr, r, lane); continue; } r -= I_OUT;
            if (r < I_OUT) { p0_transpose_item(args.in[21], DM, W_OUT, 2048, 1024, 0, 0, scr, r, lane); continue; } r -= I_OUT;
            p0_transpose_item(args.in[13], 512, (bf16*)(ws + WS_G2T), 128, 0, 0, 0, scr, r, lane);
        }
        for (int m = gw; m < NTOK; m += NGW) {
            const float* xrow = (m < NTOK_P) ? xp + (size_t)m * DM : xs + (size_t)(m - NTOK_P) * DM;
            const GAS f32x4* xr = (const GAS f32x4*)xrow + lane; GAS unsigned long long* o8 = (GAS unsigned long long*)(XB + (size_t)m * DM) + lane;
#pragma unroll
            for (int j = 0; j < 4; ++j) { const f32x4 v = xr[64 * j]; o8[64 * j] = (unsigned long long)pk2(v.x, v.y) | ((unsigned long long)pk2(v.z, v.w) << 32); }
        }
        for (int e = gtid; e < 4096 * 64; e += NGT) {
            const int t = e >> 6, j = e & 63;
            const float ang = (float)(1.0 / pow(10000.0, (double)j / 63.0));
            const float th = (float)t * ang;
            TAB[e] = make_float2((float)cos((double)th), (float)sin((double)th));
        }
    }
    SEAM(0);
    if (IN(1)) { pg8::Gemm g{XB, W_UP1, NTOK, 2 * DFF, DM}; pg8::StaticOrder S; S.init(NTOK, 2 * DFF, G, bx);
        pg8::EpiSwiglu E{H1, DFF}; pg8::gemm_phase<pg8::EpiSwiglu, pg8::StaticOrder, true, true>(L + RING_OFF, g, S, E); }
    SEAM(1);
    if (IN(2)) { pg8::Gemm g{H1, W_DN1, NTOK, DM, DFF}; pg8::StaticOrder S; S.init(NTOK, DM, G, bx);
        pg8::EpiResidual<0> E{xp, xs, NTOK_P, nullptr, PF, DM, ALPHA, 0.5f}; pg8::gemm_phase<pg8::EpiResidual<0>, pg8::StaticOrder, true, true>(L + RING_OFF, g, S, E); }
    SEAM(2);
    if (IN(3)) ln_rows(PF, args.in[4], args.in[5], nullptr, X1B, gw, NGW, lane);
    SEAM(3);
    if (IN(4)) { pg8::Gemm g{X1B, W_IN + (size_t)RWKV_COLS * DM, NTOK, RET_COLS, DM}; pg8::StaticOrder S; S.init(NTOK, RET_COLS, G, bx);
        pg8::EpiStoreBf16<false> E{UR, RET_COLS, nullptr}; pg8::gemm_phase<pg8::EpiStoreBf16<false>, pg8::StaticOrder, true, true>(L + RING_OFF, g, S, E); }
    SEAM(4);
    if (IN(5)) rope_phase(UR, TAB, gtid, NGT);
    SEAM(5);
    if (IN(6)) ret_kv_phase(L + RING_OFF, UR, (bf16*)(dout + DO_KV), vcu, G);
    SEAM(6);
    if (IN(7)) ret_scan_phase((bf16*)(dout + DO_KV), gtid, NGT);
    SEAM(7);
    if (IN(8)) ret_out_phase(L + RING_OFF, UR, (const bf16*)(dout + DO_KV), YB, vcu, G);
    SEAM(8);
    if (IN(9)) { pg8::Gemm g{X1B, W_IN, NTOK, RWKV_COLS, DM}; pg8::StaticOrder S; S.init(NTOK, RWKV_COLS, G, bx);
        pg8::EpiStoreBf16<true> E{UA, RWKV_COLS, (bf16*)(ws + WS_HALO)}; pg8::gemm_phase<pg8::EpiStoreBf16<true>, pg8::StaticOrder, true, true>(L + RING_OFF, g, S, E); }
    SEAM(9);
    if (IN(10)) shift_phase(UA, (const bf16*)(ws + WS_HALO), args.in[7], args.in[8], gtid, NGT);
    SEAM(10);
    if (IN(11)) scan_phase(L + RING_OFF, UA, args.in, (bf16*)(dout + DO_YF), (bf16*)(dout + DO_YBW), (float*)(ws + WS_BONUS), bx, G);
    SEAM(11);
    if (IN(12)) post_phase(L + RING_OFF, UA, args.in, (const bf16*)(ws + WS_G2T), (const bf16*)(dout + DO_YF), (const bf16*)(dout + DO_YBW), (const float*)(ws + WS_BONUS), YA, vcu, G);
    SEAM(12);
    if (IN(13)) {
        { pg8::Gemm g{YA, W_BR, NTOK, DM, 512}; pg8::StaticOrder S; S.init(NTOK, DM, G, bx);
          pg8::EpiStoreBf16<false> E{HB, 2048, nullptr}; pg8::gemm_phase<pg8::EpiStoreBf16<false>, pg8::StaticOrder, true, true>(L + RING_OFF, g, S, E); }
        { pg8::Gemm g{YB, W_BR + (size_t)1024 * 512, NTOK, DM, 512}; pg8::StaticOrder S; S.init(NTOK, DM, G, bx);
          pg8::EpiStoreBf16<false> E{HB + 1024, 2048, nullptr}; pg8::gemm_phase<pg8::EpiStoreBf16<false>, pg8::StaticOrder, true, true>(L + RING_OFF, g, S, E); }
    }
    SEAM(13);
    if (IN(14)) { pg8::Gemm g{X1B, W_IN + (size_t)(RWKV_COLS + RET_COLS) * DM, NTOK, GATE_COLS, DM}; pg8::StaticOrder S; S.init(NTOK, GATE_COLS, G, bx);
        pg8::EpiGateMul E{HB, 2048}; pg8::gemm_phase<pg8::EpiGateMul, pg8::StaticOrder, true, true>(L + RING_OFF, g, S, E); }
    SEAM(14);
    if (IN(15)) { pg8::Gemm g{HB, W_OUT, NTOK, DM, 2048}; pg8::StaticOrder S; S.init(NTOK, DM, G, bx);
        pg8::EpiResidual<1> E{nullptr, nullptr, 0, X1B, PF, DM, ALPHA, 1.0f}; pg8::gemm_phase<pg8::EpiResidual<1>, pg8::StaticOrder, true, true>(L + RING_OFF, g, S, E); }
    SEAM(15);
    if (IN(16)) ln_rows(PF, args.in[22], args.in[23], PF, X2B, gw, NGW, lane);
    SEAM(16);
    if (IN(17)) { pg8::Gemm g{X2B, W_UP2, NTOK, 2 * DFF, DM}; pg8::StaticOrder S; S.init(NTOK, 2 * DFF, G, bx);
        pg8::EpiSwiglu E{H2, DFF}; pg8::gemm_phase<pg8::EpiSwiglu, pg8::StaticOrder, true, true>(L + RING_OFF, g, S, E); }
    SEAM(17);
    if (IN(18)) { LAS float* scr = (LAS float*)(L + RING_OFF + wave * 16384);
        for (int it = gw; it < 44 * 32; it += NGW) p0_transpose_item(args.in[25], DM, W_DN2, DFF, 0, 0, 0, scr, it, lane); }
    SEAM(18);
    if (IN(19)) { pg8::Gemm g{H2, W_DN2, NTOK, DM, DFF}; pg8::StaticOrder S; S.init(NTOK, DM, G, bx);
        pg8::EpiResidual<0> E{PF, PF, NTOK, nullptr, PF, DM, ALPHA, 0.5f}; pg8::gemm_phase<pg8::EpiResidual<0>, pg8::StaticOrder, true, true>(L + RING_OFF, g, S, E); }
    SEAM(19);
    if (IN(20)) ln_rows(PF, args.in[26], args.in[27], PF, nullptr, gw, NGW, lane);
#undef IN
#undef SEAM
}

#ifndef MK_FUSE
#define MK_FUSE 1
#endif
extern "C" void kernel_launch(void* const* d_in, const int* in_sizes, int n_in, void* d_out, int out_size, void* d_ws, size_t ws_size, hipStream_t stream) {
    static int grid = 0;
    if (grid == 0) {
        if (n_in != 28 || out_size != NTOK * DM || ws_size < WS_END) { fprintf(stderr, "kernel_launch: unexpected problem (n_in %d, out %d, ws %zu); nothing launched\n", n_in, out_size, ws_size); grid = -1; return; }
        int dev = 0, cus = 0, per_cu = 0;
        if (hipGetDevice(&dev) != hipSuccess || hipDeviceGetAttribute(&cus, hipDeviceAttributeMultiprocessorCount, dev) != hipSuccess) { grid = -1; return; }
        if (hipFuncSetAttribute((const void*)mk, hipFuncAttributeMaxDynamicSharedMemorySize, LDS_BYTES) != hipSuccess) { fprintf(stderr, "kernel_launch: hipFuncSetAttribute failed\n"); grid = -1; return; }
        if (hipOccupancyMaxActiveBlocksPerMultiprocessor(&per_cu, (const void*)mk, NWAVES * 64, LDS_BYTES) != hipSuccess || per_cu < 1) { fprintf(stderr, "kernel_launch: occupancy query says %d blocks per CU\n", per_cu); }
        (void)hipGetLastError();
        grid = cus;
    }
    if (grid < 0) return;
    (void)hipMemsetAsync((char*)d_ws + WS_CTL, 0, CTL_ZERO_BYTES, stream);
    Args a{};
    for (int i = 0; i < 28; ++i) a.in[i] = (const float*)d_in[i];
    a.out = (float*)d_out; a.ws = (unsigned char*)d_ws;
    int li = 0;
    auto run = [&](int lo, int hi) {
#if MK_FUSE
        a.ph_lo = lo; a.ph_hi = hi; a.li = li++; hipLaunchKernelGGL(mk, dim3(grid), dim3(NWAVES * 64), LDS_BYTES, stream, a);
#else
        for (int k = lo; k < hi; ++k) { a.ph_lo = k; a.ph_hi = k + 1; a.li = 0; hipLaunchKernelGGL(mk, dim3(grid), dim3(NWAVES * 64), LDS_BYTES, stream, a); }
#endif
    };
#ifdef PROBE_PHASE
    run(0, PROBE_PHASE + 1); run(PROBE_PHASE, PROBE_PHASE + 1); run(PROBE_PHASE, PROBE_PHASE + 1); if (PROBE_PHASE + 1 < N_PHASES) run(PROBE_PHASE + 1, N_PHASES);
#else
    run(0, N_PHASES);
#endif

}
```
